# Optimizing an MI355X kernel written in HIP

```python
import jax
import jax.numpy as jnp
from jax import lax
import numpy as np

D_MODEL = 1024
BATCH = 16
SEQ = 2048
DEPTH = 2

D_GROUP = D_MODEL // 4
HEAD_DIM = 64
N_GROUP_HEADS = D_GROUP // HEAD_DIM

RWKV_LORA_DECAY = 64
RWKV_LORA_AAA = 64
RWKV_LORA_GATE = 128
RWKV_LN_EPS = 64e-5

DILATED_PATTERNS = ((128, 1), (512, 4), (2048, 16))

MLA_Q_RANK = D_MODEL // 4
MLA_KV_RANK = D_MODEL // 8
MLA_NOPE_DIM = 64
MLA_ROPE_DIM = 32
MLA_V_DIM = D_GROUP // N_GROUP_HEADS

HGRN_CHUNK = 16

D_FF = 2816
N_EXPERTS = 8
TOP_K = 2
D_FF_EXPERT = 3584

ROPE_THETA = 10000.0
RMS_EPS = 1e-6
ATTN_BLOCK = 128
NEG_INF = -1e30

RWKV_COLS = (D_GROUP, D_GROUP, D_GROUP, RWKV_LORA_DECAY, RWKV_LORA_AAA, RWKV_LORA_GATE)
N_RWKV_COLS = sum(RWKV_COLS)
N_DIL_COLS = 3 * D_GROUP
MLA_COLS = (MLA_Q_RANK, MLA_KV_RANK, MLA_ROPE_DIM)
N_MLA_COLS = sum(MLA_COLS)
N_HGRN_COLS = 4 * D_GROUP
MIXER_COLS = (N_RWKV_COLS, N_DIL_COLS, N_MLA_COLS, N_HGRN_COLS)
N_IN_COLS = sum(MIXER_COLS)
N_DENSE_LAYERS = (DEPTH + 1) // 2
N_MOE_LAYERS = DEPTH // 2

kernel_name = 'hybrid_rwkv7_dilated_mla_hgrn2_moe'


def split_cols(a, sizes):
    out, start = [], 0
    for s in sizes:
        out.append(a[..., start:start + s])
        start += s
    return out


def rms_norm(x, w):
    xf = x.astype(jnp.float32)
    y = xf * lax.rsqrt(jnp.mean(xf * xf, axis=-1, keepdims=True) + RMS_EPS)
    return (y * w).astype(x.dtype)


def rope_tables(positions, dim):
    inv_freq = 1.0 / (ROPE_THETA ** (jnp.arange(0, dim, 2, dtype=jnp.float32) / dim))
    ang = positions.astype(jnp.float32)[..., None] * inv_freq
    return jnp.cos(ang), jnp.sin(ang)


def apply_rope(x, cos, sin):
    half = x.shape[-1] // 2
    x1 = x[..., :half].astype(jnp.float32)
    x2 = x[..., half:].astype(jnp.float32)
    c, s = cos[:, None], sin[:, None]
    return jnp.concatenate([x1 * c - x2 * s, x2 * c + x1 * s], axis=-1).astype(x.dtype)


def to_heads(t, n_heads):
    b, s, _ = t.shape
    return t.reshape(b, s, n_heads, -1).transpose(0, 2, 1, 3)


def token_shift(a, mu):
    prev = jnp.pad(a, ((0, 0), (1, 0), (0, 0)))[:, :-1]
    return a + (prev - a) * mu


def rwkv7_time_mix(cols, mu, w0, w2, a0, a2, g2, k_k, k_a, r_k, ln_w, ln_b):
    b_, t_, _ = cols.shape
    h_, n_ = N_GROUP_HEADS, HEAD_DIM
    r, k, v, xw, xa, xg = split_cols(token_shift(cols, mu), RWKV_COLS)
    w = -jax.nn.softplus(-(w0 + jnp.tanh(xw) @ w2).astype(jnp.float32)) - 0.5
    decay = jnp.exp(-jnp.exp(w))
    a = jax.nn.sigmoid((a0 + xa @ a2).astype(jnp.float32))
    g = (jax.nn.sigmoid(xg) @ g2).astype(jnp.float32)
    heads = lambda t: t.reshape(b_, t_, h_, n_)
    kk = heads((k * k_k).astype(jnp.float32))
    kk = kk / jnp.maximum(jnp.sqrt(jnp.sum(kk * kk, axis=-1, keepdims=True)), 1e-12)
    k = k.astype(jnp.float32) * (1.0 + (a - 1.0) * k_a)
    r_h, k_h, v_h = heads(r.astype(jnp.float32)), heads(k), heads(v.astype(jnp.float32))
    w_h, a_h = heads(decay), heads(a)

    def step(state, inp):
        r_t, w_t, k_t, v_t, kk_t, a_t = inp
        s_kk = jnp.einsum('bhvk,bhk->bhv', state, kk_t)
        state = (state * w_t[:, :, None, :]
                 - s_kk[..., None] * (kk_t * a_t)[:, :, None, :]
                 + v_t[..., None] * k_t[:, :, None, :])
        return state, jnp.einsum('bhvk,bhk->bhv', state, r_t)

    xs = tuple(jnp.moveaxis(t, 1, 0) for t in (r_h, w_h, k_h, v_h, kk, a_h))
    s0 = jnp.zeros((b_, h_, n_, n_), jnp.float32)
    _, y = lax.scan(step, s0, xs)
    y = jnp.moveaxis(y, 0, 1)
    mean = jnp.mean(y, axis=-1, keepdims=True)
    var = jnp.mean((y - mean) ** 2, axis=-1, keepdims=True)
    y = ((y - mean) * lax.rsqrt(var + RWKV_LN_EPS)).reshape(b_, t_, D_GROUP) * ln_w + ln_b
    bonus = jnp.sum(r_h * k_h * r_k.reshape(h_, n_), axis=-1, keepdims=True) * v_h
    y = y + bonus.reshape(b_, t_, D_GROUP)
    return (y * g).astype(cols.dtype)


def banded_causal_attention(q, k, v, span):
    *lead, l_, hd = q.shape
    blk = span
    nb = -(-l_ // blk)
    pad = nb * blk - l_
    padw = [(0, 0)] * len(lead) + [(0, pad), (0, 0)]
    q, k, v = (jnp.pad(t, padw).reshape(*lead, nb, blk, hd) for t in (q, k, v))

    def with_prev(t):
        prev = jnp.concatenate([jnp.zeros_like(t[..., :1, :, :]), t[..., :-1, :, :]], axis=-3)
        return jnp.concatenate([prev, t], axis=-2)

    kb, vb = with_prev(k), with_prev(v).astype(jnp.float32)
    s = jnp.einsum('...qd,...kd->...qk', q, kb).astype(jnp.float32) * (hd ** -0.5)
    dist = (jnp.arange(blk)[:, None] + blk) - jnp.arange(2 * blk)[None, :]
    in_band = (dist >= 0) & (dist <= span)
    after_start = (jnp.arange(nb)[:, None, None] > 0) | (jnp.arange(2 * blk)[None, None, :] >= blk)
    s = jnp.where(in_band & after_start, s, NEG_INF)
    m = jnp.max(s, axis=-1, keepdims=True)
    p = jnp.exp(s - m)
    den = jnp.sum(p, axis=-1, keepdims=True)
    o = jnp.einsum('...qk,...kd->...qd', p, vb) / den
    lse = (m + jnp.log(den))[..., 0]
    o = o.reshape(*lead, nb * blk, hd)[..., :l_, :]
    lse = lse.reshape(*lead, nb * blk)[..., :l_]
    return o, lse


def dilated_attention(q, k, v):
    b_, h_, t_, hd = q.shape
    outs, lses = [], []
    for window, dil in DILATED_PATTERNS:
        l_ = t_ // dil

        def fold(a):
            return a.reshape(b_, h_, l_, dil, hd).swapaxes(2, 3)

        o, lse = banded_causal_attention(fold(q), fold(k), fold(v), window // dil)
        outs.append(o.swapaxes(2, 3).reshape(b_, h_, t_, hd))
        lses.append(lse.swapaxes(2, 3).reshape(b_, h_, t_))
    weights = jax.nn.softmax(jnp.stack(lses), axis=0)
    return jnp.sum(weights[..., None] * jnp.stack(outs), axis=0)


def blocked_causal_attention(q, k, v):
    b_, h_, t_, dq = q.shape
    nb = t_ // ATTN_BLOCK
    qb = jnp.moveaxis(q.reshape(b_, h_, nb, ATTN_BLOCK, dq), 2, 0)
    vf = v.astype(jnp.float32)
    kpos = jnp.arange(t_)
    scale = dq ** -0.5

    def attend(args):
        q_blk, blk_idx = args
        s = jnp.einsum('bhqd,bhkd->bhqk', q_blk, k).astype(jnp.float32) * scale
        qpos = blk_idx * ATTN_BLOCK + jnp.arange(ATTN_BLOCK)
        s = jnp.where(kpos[None, :] <= qpos[:, None], s, NEG_INF)
        return jnp.einsum('bhqk,bhkd->bhqd', jax.nn.softmax(s, axis=-1), vf)

    o = lax.map(attend, (qb, jnp.arange(nb)))
    return jnp.moveaxis(o, 0, 2).reshape(b_, h_, t_, v.shape[-1])


def mla_attention(cols, q_norm, w_uq, kv_norm, w_ukv, cos_r, sin_r):
    b_, t_, _ = cols.shape
    h_ = N_GROUP_HEADS
    c_q, c_kv, k_rope = split_cols(cols, MLA_COLS)
    q = to_heads(rms_norm(c_q, q_norm) @ w_uq, h_)
    kv = to_heads(rms_norm(c_kv, kv_norm) @ w_ukv, h_)
    q_nope, q_rope = q[..., :MLA_NOPE_DIM], q[..., MLA_NOPE_DIM:]
    k_nope, v = kv[..., :MLA_NOPE_DIM], kv[..., MLA_NOPE_DIM:]
    q_rope = apply_rope(q_rope, cos_r, sin_r)
    k_rope = apply_rope(k_rope[:, None], cos_r, sin_r)
    qf = jnp.concatenate([q_nope, q_rope], axis=-1)
    kf = jnp.concatenate([k_nope, jnp.broadcast_to(k_rope, (b_, h_, t_, MLA_ROPE_DIM))], axis=-1)
    o = blocked_causal_attention(qf, kf, v)
    return o.transpose(0, 2, 1, 3).reshape(b_, t_, h_ * MLA_V_DIM).astype(cols.dtype)


def gated_linear_recurrence_chunked(q, k, v, log_f):
    b_, h_, t_, dk = q.shape
    dv = v.shape[-1]
    c_ = HGRN_CHUNK
    n_ = t_ // c_
    q, k, v, log_f = (t.reshape(b_, h_, n_, c_, t.shape[-1]) for t in (q, k, v, log_f))
    b = jnp.cumsum(log_f, axis=3)
    b_end = b[:, :, :, c_ - 1:]
    causal = jnp.tril(jnp.ones((c_, c_), dtype=bool))[:, :, None]
    diff = b[:, :, :, :, None, :] - b[:, :, :, None, :, :]
    intra_decay = jnp.exp(jnp.where(causal, diff, NEG_INF))
    scores = jnp.einsum('bhnck,bhnsk,bhncsk->bhncs', q, k, intra_decay)
    o_intra = jnp.einsum('bhncs,bhnsv->bhncv', scores, v)
    chunk_update = jnp.einsum('bhnsk,bhnsv->bhnkv', k * jnp.exp(b_end - b), v)
    chunk_decay = jnp.exp(b_end[:, :, :, 0])

    def step(state, inp):
        upd, dec = inp
        return state * dec[..., None] + upd, state

    s0 = jnp.zeros((b_, h_, dk, dv), q.dtype)
    _, s_start = lax.scan(step, s0, (jnp.moveaxis(chunk_update, 2, 0), jnp.moveaxis(chunk_decay, 2, 0)))
    o_inter = jnp.einsum('bhnck,nbhkv->bhncv', q * jnp.exp(b), s_start)
    return (o_intra + o_inter).reshape(b_, h_, t_, dv)


def hgrn2_mixer(cols, lower_bound, g_norm):
    b_, t_, _ = cols.shape
    h_, n_ = N_GROUP_HEADS, HEAD_DIM
    q, f, i, g = split_cols(cols, (D_GROUP,) * 4)
    heads = lambda t: to_heads(t, h_).astype(jnp.float32)
    z = heads(f)
    lb = lower_bound.astype(jnp.float32).reshape(h_, n_)[:, None, :]
    forget = lb + (1.0 - lb) * jax.nn.sigmoid(z)
    log_f = jnp.log(forget)
    k = 1.0 - forget
    o = gated_linear_recurrence_chunked(heads(jax.nn.silu(q)), k, heads(i), log_f)
    o = o * lax.rsqrt(jnp.mean(o * o, axis=-1, keepdims=True) + RMS_EPS)
    o = o.transpose(0, 2, 1, 3).reshape(b_, t_, D_GROUP) * g_norm
    return (o * jax.nn.silu(g)).astype(cols.dtype)


def swiglu(h, w1, w3, w2):
    return (jax.nn.silu(h @ w1) * (h @ w3)) @ w2


def moe_swiglu(h, w_router, w1, w3, w2):
    logits = (h @ w_router).astype(jnp.float32)
    top_v, top_i = lax.top_k(logits, TOP_K)
    gates = jax.nn.softmax(top_v, axis=-1)
    combine = jnp.sum(jax.nn.one_hot(top_i, N_EXPERTS, dtype=jnp.float32) * gates[..., None], axis=-2)
    out = jnp.zeros_like(h)
    for e in range(N_EXPERTS):
        out = out + combine[..., e:e + 1].astype(h.dtype) * swiglu(h, w1[e], w3[e], w2[e])
    return out


def setup_inputs(seed: int = 0) -> dict:
    key = jax.random.key(seed)
    keys = jax.random.split(key, 40)
    counter = [0]

    def nxt():
        kk = keys[counter[0]]
        counter[0] += 1
        return kk

    def nrm(shape, scale):
        return scale * jax.random.normal(nxt(), shape, jnp.float32)

    def gain(shape):
        return 1.0 + 0.02 * jax.random.normal(nxt(), shape, jnp.float32)

    x = nrm((BATCH, SEQ, D_MODEL), 1.0)
    positions = (jax.random.randint(nxt(), (BATCH, 1), 0, SEQ, dtype=jnp.int32)
                 + jnp.arange(SEQ, dtype=jnp.int32)[None, :])
    return {
        'x': x,
        'positions': positions,
        'mix_norm': gain((DEPTH, D_MODEL)),
        'w_in': nrm((DEPTH, D_MODEL, N_IN_COLS), D_MODEL ** -0.5),
        'w_out': nrm((DEPTH, D_MODEL, D_MODEL), D_MODEL ** -0.5),
        'rwkv_mu': jax.random.uniform(nxt(), (DEPTH, N_RWKV_COLS), jnp.float32),
        'rwkv_w0': nrm((DEPTH, D_GROUP), 0.5) - 1.0,
        'rwkv_w2': nrm((DEPTH, RWKV_LORA_DECAY, D_GROUP), 0.5 * RWKV_LORA_DECAY ** -0.5),
        'rwkv_a0': nrm((DEPTH, D_GROUP), 0.1),
        'rwkv_a2': nrm((DEPTH, RWKV_LORA_AAA, D_GROUP), RWKV_LORA_AAA ** -0.5),
        'rwkv_g2': nrm((DEPTH, RWKV_LORA_GATE, D_GROUP), RWKV_LORA_GATE ** -0.5),
        'rwkv_k_k': nrm((DEPTH, D_GROUP), 0.05) + 0.85,
        'rwkv_k_a': gain((DEPTH, D_GROUP)),
        'rwkv_r_k': nrm((DEPTH, D_GROUP), 0.1),
        'rwkv_ln_w': gain((DEPTH, D_GROUP)),
        'rwkv_ln_b': nrm((DEPTH, D_GROUP), 0.02),
        'mla_q_norm': gain((DEPTH, MLA_Q_RANK)),
        'mla_w_uq': nrm((DEPTH, MLA_Q_RANK, N_GROUP_HEADS * (MLA_NOPE_DIM + MLA_ROPE_DIM)), MLA_Q_RANK ** -0.5),
        'mla_kv_norm': gain((DEPTH, MLA_KV_RANK)),
        'mla_w_ukv': nrm((DEPTH, MLA_KV_RANK, N_GROUP_HEADS * (MLA_NOPE_DIM + MLA_V_DIM)), MLA_KV_RANK ** -0.5),
        'hgrn_lb_logits': nrm((DEPTH, D_GROUP), 1.0),
        'hgrn_g_norm': gain((DEPTH, D_GROUP)),
        'ffn_norm': gain((DEPTH, D_MODEL)),
        'ffn_w1': nrm((N_DENSE_LAYERS, D_MODEL, D_FF), D_MODEL ** -0.5),
        'ffn_w3': nrm((N_DENSE_LAYERS, D_MODEL, D_FF), D_MODEL ** -0.5),
        'ffn_w2': nrm((N_DENSE_LAYERS, D_FF, D_MODEL), D_FF ** -0.5),
        'moe_router': nrm((N_MOE_LAYERS, D_MODEL, N_EXPERTS), D_MODEL ** -0.5),
        'moe_w1': nrm((N_MOE_LAYERS, N_EXPERTS, D_MODEL, D_FF_EXPERT), D_MODEL ** -0.5),
        'moe_w3': nrm((N_MOE_LAYERS, N_EXPERTS, D_MODEL, D_FF_EXPERT), D_MODEL ** -0.5),
        'moe_w2': nrm((N_MOE_LAYERS, N_EXPERTS, D_FF_EXPERT, D_MODEL), D_FF_EXPERT ** -0.5),
        'final_norm': gain((D_MODEL,)),
    }


def reference(x, positions, mix_norm, w_in, w_out, rwkv_mu, rwkv_w0, rwkv_w2, rwkv_a0, rwkv_a2,
              rwkv_g2, rwkv_k_k, rwkv_k_a, rwkv_r_k, rwkv_ln_w, rwkv_ln_b, mla_q_norm, mla_w_uq,
              mla_kv_norm, mla_w_ukv, hgrn_lb_logits, hgrn_g_norm, ffn_norm, ffn_w1, ffn_w3, ffn_w2,
              moe_router, moe_w1, moe_w3, moe_w2, final_norm):
    b_, t_, _ = x.shape
    cos_d, sin_d = rope_tables(positions, HEAD_DIM)
    cos_m, sin_m = rope_tables(positions, MLA_ROPE_DIM)
    lb_sm = jax.nn.softmax(hgrn_lb_logits.astype(jnp.float32), axis=0)
    lower_bounds = jnp.cumsum(lb_sm, axis=0) - lb_sm[0]
    for layer in range(DEPTH):
        h = rms_norm(x, mix_norm[layer])
        c_rwkv, c_dil, c_mla, c_hgrn = split_cols(h @ w_in[layer], MIXER_COLS)
        y_a = rwkv7_time_mix(c_rwkv, rwkv_mu[layer], rwkv_w0[layer], rwkv_w2[layer], rwkv_a0[layer],
                             rwkv_a2[layer], rwkv_g2[layer], rwkv_k_k[layer], rwkv_k_a[layer],
                             rwkv_r_k[layer], rwkv_ln_w[layer], rwkv_ln_b[layer])
        q_d, k_d, v_d = (to_heads(t, N_GROUP_HEADS) for t in split_cols(c_dil, (D_GROUP,) * 3))
        y_b = dilated_attention(apply_rope(q_d, cos_d, sin_d), apply_rope(k_d, cos_d, sin_d), v_d)
        y_b = y_b.transpose(0, 2, 1, 3).reshape(b_, t_, D_GROUP).astype(x.dtype)
        y_c = mla_attention(c_mla, mla_q_norm[layer], mla_w_uq[layer], mla_kv_norm[layer],
                            mla_w_ukv[layer], cos_m, sin_m)
        y_d = hgrn2_mixer(c_hgrn, lower_bounds[layer], hgrn_g_norm[layer])
        x = x + jnp.concatenate([y_a, y_b, y_c, y_d], axis=-1) @ w_out[layer]
        h = rms_norm(x, ffn_norm[layer])
        if layer % 2 == 0:
            j = layer // 2
            x = x + swiglu(h, ffn_w1[j], ffn_w3[j], ffn_w2[j])
        else:
            j = layer // 2
            x = x + moe_swiglu(h, moe_router[j], moe_w1[j], moe_w3[j], moe_w2[j])
    return rms_norm(x, final_norm)
```

```cpp
#include <hip/hip_runtime.h>
#include <cstdio>
#include <cstdint>

#define CLS_EN(c) (CLS < 0 || CLS == (c))
#ifndef MK_ONE_LAUNCH
#define MK_ONE_LAUNCH 0
#endif

#define GAS __attribute__((address_space(1)))
#define LAS __attribute__((address_space(3)))
typedef unsigned short bf16;
typedef unsigned v4u __attribute__((ext_vector_type(4)));
typedef unsigned v2u __attribute__((ext_vector_type(2)));
typedef float f32x2 __attribute__((ext_vector_type(2)));
typedef float f32x4 __attribute__((ext_vector_type(4)));
typedef float f32x16 __attribute__((ext_vector_type(16)));
typedef short bf16x8 __attribute__((ext_vector_type(8)));
typedef short s16x4 __attribute__((ext_vector_type(4)));

constexpr int D = 1024, NB = 16, T = 2048, M = NB * T, DEPTH = 2;
constexpr int NIN = 3232, NINP = 3328;
constexpr int FF = 2816, FFE = 3584, NEXP = 8;
constexpr int MAXT = 135;
constexpr int MAXROWS = MAXT * 256;

constexpr size_t MiB = 1u << 20;
constexpr size_t WS_CTL = 0, CTL_ZERO_BYTES = 256 * 1024;
constexpr size_t WS_WIN = 1 * MiB;
constexpr size_t WS_WOUT = 14 * MiB;
constexpr size_t WS_WLORA = 18 * MiB;
constexpr size_t WS_WMLA = 19 * MiB;
constexpr size_t WS_W13D = 21 * MiB;
constexpr size_t WS_W2D = 32 * MiB;
constexpr size_t WS_ROPE = 38 * MiB;
constexpr size_t WS_MISC = 50 * MiB;
constexpr size_t WS_H = 52 * MiB;
constexpr size_t WS_CR = 116 * MiB;
constexpr size_t WS_CD = 180 * MiB;
constexpr size_t WS_CM = 228 * MiB;
constexpr size_t WS_CH = 260 * MiB;
constexpr size_t WS_AL = 324 * MiB;
constexpr size_t WS_LO = 340 * MiB;
constexpr size_t WS_QM = 388 * MiB;
constexpr size_t WS_KVM = 412 * MiB;
constexpr size_t WS_OPR = 180 * MiB, WS_OPK = 196 * MiB, WS_OPV = 212 * MiB, WS_OPKK = 228 * MiB, WS_OPKA = 244 * MiB;
constexpr size_t WS_OPW = 388 * MiB;
constexpr size_t WS_YRA = 116 * MiB, WS_YRH = 148 * MiB;
constexpr size_t WS_ACT = 116 * MiB;
constexpr size_t WS_WM13 = 356 * MiB;
constexpr size_t WS_WM2 = 468 * MiB;
constexpr size_t WS_END = 524 * MiB;
static_assert(WS_ACT + (size_t)MAXROWS * FFE * 2 <= WS_WM13, "act vs wm13");
constexpr size_t MS_RS = WS_MISC;
constexpr size_t MS_TOPE = WS_MISC + 256 * 1024;
constexpr size_t MS_GATE = WS_MISC + 512 * 1024;
constexpr size_t MS_RANK = WS_MISC + 768 * 1024;
constexpr size_t MS_RTOK = WS_MISC + 1024 * 1024;
constexpr size_t MS_RGATE = WS_MISC + 1024 * 1024 + 320 * 1024;
static_assert((size_t)2 * MAXROWS * 4 <= 320 * 1024 && MS_RGATE + 320 * 1024 <= WS_H, "misc map");
constexpr int CW_CNT = 64;
constexpr int CW_BAR = 4096;

constexpr int RING_BYTES = 131072;
constexpr int TAB_OFF = RING_BYTES, TAB_BYTES = 16 * 1024;
constexpr int MISC_OFF = TAB_OFF + TAB_BYTES;
constexpr int LDS_BYTES = MISC_OFF + 1024;
constexpr int NWAVES = 8;

#define LDS_WAIT() asm volatile("s_waitcnt lgkmcnt(0)" ::: "memory")
#define VM_WAIT() asm volatile("s_waitcnt vmcnt(0)" ::: "memory")
__device__ __forceinline__ unsigned f2bf(float f) { unsigned u = __builtin_bit_cast(unsigned, f); return (u + 0x7fffu + ((u >> 16) & 1u)) >> 16; }
__device__ __forceinline__ unsigned pk2(float lo, float hi) { return f2bf(lo) | (f2bf(hi) << 16); }
__device__ __forceinline__ float bf2f(unsigned b) { return __builtin_bit_cast(float, b << 16); }
__device__ __forceinline__ float bflo(unsigned w) { return __builtin_bit_cast(float, w << 16); }
__device__ __forceinline__ float bfhi(unsigned w) { return __builtin_bit_cast(float, w & 0xffff0000u); }
__device__ __forceinline__ unsigned cvt_pk_bf16(float lo, float hi) { unsigned r; asm volatile("v_cvt_pk_bf16_f32 %0, %1, %2" : "=v"(r) : "v"(lo), "v"(hi)); return r; }
__device__ __forceinline__ float fexp(float x) { return __builtin_amdgcn_exp2f(x * 1.4426950408889634f); }
__device__ __forceinline__ float frcp(float x) { return __builtin_amdgcn_rcpf(x); }
__device__ __forceinline__ float sigmoidf_(float x) { return frcp(1.0f + fexp(-x)); }
__device__ __forceinline__ float siluf_(float x) { return x * sigmoidf_(x); }
__device__ __forceinline__ float tanhf_(float x) { return 1.0f - 2.0f * frcp(1.0f + fexp(2.0f * x)); }
__device__ __forceinline__ float wave_sum(float v) {
#pragma unroll
    for (int o = 1; o < 64; o <<= 1) v += __shfl_xor(v, o);
    return v;
}
template <int CTRL> __device__ __forceinline__ float dpp_f(float v) { return __builtin_bit_cast(float, __builtin_amdgcn_update_dpp(0, __builtin_bit_cast(int, v), CTRL, 0xf, 0xf, false)); }
__device__ __forceinline__ float row16_sum(float v) {
    v += dpp_f<0x128>(v);
    v += dpp_f<0x124>(v);
    v += dpp_f<0x122>(v);
    v += dpp_f<0x121>(v);
    return v;
}

#define XB_TMO      128
#define XB_XCNT(j)  (256  + 64 * (j))
#define XB_XSUB(j)  (1280 + 64 * (j))
#define XB_XGEN(j)  (2304 + 64 * (j))
#define XB_TOP      3328
#define XB_TOPGEN   3392
#define XCD_BAR_WORDS 3456
#define XB_SPIN_CAP (1u << 18)
__device__ __forceinline__ unsigned xb_ld(unsigned* p)              { return __hip_atomic_load(p, __ATOMIC_RELAXED, __HIP_MEMORY_SCOPE_AGENT); }
__device__ __forceinline__ unsigned xb_add(unsigned* p, unsigned v) { return __hip_atomic_fetch_add(p, v, __ATOMIC_RELAXED, __HIP_MEMORY_SCOPE_AGENT); }
__device__ __forceinline__ unsigned xb_xcc_id() { return (unsigned)__builtin_amdgcn_s_getreg((3 << 11) | 20) & 0xFu; }
#define XB_SPIN(cond, bar) do { unsigned _sp = 0; while (cond) { __builtin_amdgcn_s_sleep(1); \
    if ((++_sp & 255u) == 0u) { if (xb_ld(&(bar)[XB_TMO])) break; if (_sp > XB_SPIN_CAP) { atomicAdd(&(bar)[XB_TMO], 1u); break; } } } } while (0)
struct XcdBarrier { unsigned* bar; unsigned x; volatile LAS unsigned* st; };
__device__ __forceinline__ XcdBarrier xcd_barrier_post(unsigned* bar, volatile LAS unsigned* st) {
    XcdBarrier b; b.bar = bar; b.x = xb_xcc_id(); b.st = st;
    if (threadIdx.x == 0) (void)xb_add(&bar[XB_XCNT(b.x)], 1u);
    return b;
}
__device__ __forceinline__ void xcd_barrier_complete(unsigned* bar, unsigned x, unsigned& nloc, unsigned& nx) {
    const unsigned G = gridDim.x * gridDim.y * gridDim.z;
    unsigned sum, cnt, mine, sp = 0u;
    for (;;) {
        sum = 0u; cnt = 0u; mine = 0u;
#pragma unroll
        for (unsigned j = 0; j < 16; ++j) { const unsigned c = xb_ld(&bar[XB_XCNT(j)]); sum += c; cnt += (c > 0u) ? 1u : 0u; mine = (j == x) ? c : mine; }
        if (sum == G) break;
        __builtin_amdgcn_s_sleep(1);
        if ((++sp & 255u) == 0u) { if (xb_ld(&bar[XB_TMO])) break; if (sp > XB_SPIN_CAP) { atomicAdd(&bar[XB_TMO], 1u); break; } }
    }
    nloc = mine > 0u ? mine : 1u; nx = cnt > 0u ? cnt : 1u;
}
__device__ __forceinline__ void xcd_barrier(const XcdBarrier& b) {
    asm volatile("s_waitcnt vmcnt(0)" ::: "memory");
    __syncthreads();
    if (threadIdx.x == 0) {
        unsigned* bar = b.bar;
        __builtin_amdgcn_s_waitcnt(0);
        unsigned nloc = b.st[0], nx = b.st[1];
        if (nloc == 0u) { xcd_barrier_complete(bar, b.x, nloc, nx); b.st[0] = nloc; b.st[1] = nx; }
        const unsigned old = xb_add(&bar[XB_XSUB(b.x)], 1u);
        const unsigned gen = old / nloc;
        if (old + 1u == (gen + 1u) * nloc) {
            __builtin_amdgcn_fence(__ATOMIC_RELEASE, "agent");
            asm volatile("s_waitcnt vmcnt(0)" ::: "memory");
            const unsigned og = xb_add(&bar[XB_TOP], 1u);
            const unsigned tg = og / nx;
            if (og + 1u == (tg + 1u) * nx) xb_add(&bar[XB_TOPGEN], 1u);
            else XB_SPIN(xb_ld(&bar[XB_TOPGEN]) == tg, bar);
            __builtin_amdgcn_fence(__ATOMIC_ACQUIRE, "agent");
            xb_add(&bar[XB_XGEN(b.x)], 1u);
            asm volatile("s_waitcnt vmcnt(0)" ::: "memory");
        } else {
            XB_SPIN(xb_ld(&bar[XB_XGEN(b.x)]) == gen, bar);
            __builtin_amdgcn_fence(__ATOMIC_ACQUIRE, "agent");
            asm volatile("s_waitcnt vmcnt(0)" ::: "memory");
        }
    }
    __syncthreads();
}

namespace pg8 {
constexpr int BM = 256, BK = 64, HALF = 128, HTB = HALF * BK * 2, STAGE_BYTES = 8 * HTB, NXCD = 8, WGM = 8;
__host__ __device__ __forceinline__ int lds_byte(int r, int c) { const int st = (r >> 4) * 2 + (c >> 5), rr = r & 15, cc = c & 31, ob = rr * 64 + cc * 2; return st * 1024 + (ob ^ (((ob >> 9) & 1) << 5)); }
__host__ __device__ __forceinline__ void stage_rc(int b, int& R, int& C) { const int st = b / 1024, sb = b % 1024, swz = sb ^ (((sb >> 9) & 1) << 5); R = (st >> 1) * 16 + swz / 64; C = (st & 1) * 32 + (swz % 64) / 2; }
__host__ __device__ __forceinline__ int perm32(int rho) { const int n = rho >> 4, i = rho & 15; return 8 * (i >> 2) + 4 * n + (i & 3); }

struct Unit { int pm, pn; };
struct Gemm { const bf16* A; const bf16* Bt; int K; int lda; };

struct StaticOrder {
    int nM, nN, nwg, G, c;
    __device__ void init(int nM_, int nN_, int G_, int c_) { nM = nM_; nN = nN_; nwg = nM * nN; G = G_; c = c_; }
    __device__ bool next(int i, Unit& u) const {
        const long L = (long)i * G + c; if (L >= nwg) return false;
        int wgid = (int)L; { const int q = nwg / NXCD, r = nwg % NXCD, xcd = wgid % NXCD, off = wgid / NXCD; wgid = (xcd < r ? xcd * (q + 1) : r * (q + 1) + (xcd - r) * q) + off; }
        const int nig = WGM * nN, gid = wgid / nig, fm = gid * WGM, gsz = (nM - fm) < WGM ? (nM - fm) : WGM;
        u.pm = fm + ((wgid % nig) % gsz); u.pn = (wgid % nig) / gsz; return true;
    }
    __device__ __forceinline__ int a_tile(const Unit& u) const { return u.pm; }
    __device__ __forceinline__ int b_tile(const Unit& u) const { return u.pn; }
};
struct MoeOrder : StaticOrder {
    const LAS int* texp;
    __device__ __forceinline__ int b_tile(const Unit& u) const { return texp[u.pm] * nN + u.pn; }
};

template <class Epi, class Sched, bool GATHER = false>
__device__ __forceinline__ void gemm_phase(LAS unsigned char* lds, const Gemm g, const Sched& S, const Epi& E, const LAS int* gtab = nullptr) {
    const int tid = threadIdx.x, wid = __builtin_amdgcn_readfirstlane(tid >> 6), lane = tid & 63, wr = wid >> 2, wc = wid & 3, fr = lane & 15, fq = lane >> 4;
    const int K = g.K, nt = K / BK, lda = g.lda;
    unsigned voffB[2]; unsigned vA0[2], vA1[2];
#pragma unroll
    for (int i = 0; i < 2; ++i) { int R, C; stage_rc(tid * 16 + i * 8192, R, C); const int Rb = Epi::PERM ? ((R & ~31) + perm32(R & 31)) : R;
        voffB[i] = (unsigned)(Rb * K + C) * 2u;
        vA0[i] = (unsigned)(R * lda + C) * 2u; vA1[i] = (unsigned)((R + HALF) * lda + C) * 2u; }
    const size_t kstep = (size_t)(BK * 2);
    const size_t hstep = (size_t)HALF * K * 2;
    const size_t tstepB = 2 * hstep;
    const size_t tstepA = (size_t)BM * lda * 2;
    const unsigned ldsw = (unsigned)wid * 1024u;
    const int aoff = lds_byte(wr * 64 + fr, fq * 8), boff = lds_byte(wc * 32 + fr, fq * 8);
#define PG8_SA(b, h) (((b) * 2 + (h)) * HTB)
#define PG8_SB(b, h) ((4 + (b) * 2 + (h)) * HTB)
#define PG8_STAGE(bufoff, gbase, voff) do { _Pragma("unroll") for (int _i = 0; _i < 2; ++_i) \
        __builtin_amdgcn_global_load_lds((const unsigned*)((const char*)(gbase) + (voff)[_i]), (LAS unsigned*)(lds + (bufoff) + ldsw + _i * 8192), 16, 0, 0); } while (0)
#define PG8_LDA(dst, b, h) do { _Pragma("unroll") for (int m = 0; m < 4; ++m) _Pragma("unroll") for (int k = 0; k < 2; ++k) dst[m][k] = *(const LAS bf16x8*)(lds + PG8_SA(b, h) + aoff + m * 2048 + k * 1024); } while (0)
#define PG8_LDB(dst, b, h) do { _Pragma("unroll") for (int n = 0; n < 2; ++n) _Pragma("unroll") for (int k = 0; k < 2; ++k) dst[n][k] = *(const LAS bf16x8*)(lds + PG8_SB(b, h) + boff + n * 2048 + k * 1024); } while (0)
#define PG8_MMA(ai, bj, At, Bt) do { __builtin_amdgcn_s_setprio(1); _Pragma("unroll") for (int m = 0; m < 4; ++m) _Pragma("unroll") for (int n = 0; n < 2; ++n) _Pragma("unroll") for (int k = 0; k < 2; ++k) \
        acc[ai][bj][m][n] = __builtin_amdgcn_mfma_f32_16x16x32_bf16(Bt[n][k], At[m][k], acc[ai][bj][m][n], 0, 0, 0); __builtin_amdgcn_s_setprio(0); } while (0)
#define PG8_WAIT_V(n) asm volatile("s_waitcnt vmcnt(" #n ")" ::: "memory")
#define PG8_WAIT_L(n) asm volatile("s_waitcnt lgkmcnt(" #n ")" ::: "memory")
#define PG8_BAR __builtin_amdgcn_s_barrier()
#define PG8_SCHED __builtin_amdgcn_sched_barrier(0)
    Unit cur, nxt; int ui = 0;
    if (!S.next(0, cur)) return;
    f32x4 acc[2][2][4][2];
#pragma unroll
    for (int a = 0; a < 2; ++a)
#pragma unroll
        for (int b = 0; b < 2; ++b)
#pragma unroll
            for (int m = 0; m < 4; ++m)
#pragma unroll
                for (int n = 0; n < 2; ++n) acc[a][b][m][n] = (f32x4){0.f, 0.f, 0.f, 0.f};
    bf16x8 At[4][2], B0[2][2], B1[2][2];
    const char* cA; const char* cB = (const char*)g.Bt + (size_t)S.b_tile(cur) * tstepB;
    if constexpr (GATHER) {
        cA = (const char*)g.A;
        asm volatile("" ::: "memory");
#pragma unroll
        for (int i = 0; i < 2; ++i) { int R, C; stage_rc(tid * 16 + i * 8192, R, C); int t0 = gtab[R], t1 = gtab[HALF + R]; t0 = t0 < 0 ? 0 : t0; t1 = t1 < 0 ? 0 : t1;
            vA0[i] = (unsigned)(t0 * lda + C) * 2u; vA1[i] = (unsigned)(t1 * lda + C) * 2u; }
        asm volatile("s_waitcnt lgkmcnt(0)" ::: "memory");
    } else cA = (const char*)g.A + (size_t)S.a_tile(cur) * tstepA;
    PG8_STAGE(PG8_SB(0, 0), cB, voffB); PG8_STAGE(PG8_SA(0, 0), cA, vA0); PG8_STAGE(PG8_SB(0, 1), cB + hstep, voffB); PG8_STAGE(PG8_SA(0, 1), cA, vA1);
    if (wr == 1) PG8_BAR;
    PG8_WAIT_V(4); PG8_BAR;
    PG8_STAGE(PG8_SB(1, 0), cB + kstep, voffB); PG8_STAGE(PG8_SA(1, 0), cA + kstep, vA0); PG8_STAGE(PG8_SB(1, 1), cB + hstep + kstep, voffB);
    PG8_WAIT_V(6); PG8_BAR;
    for (;;) {
        const bool has_next = S.next(ui + 1, nxt);
        const char* nA; const char* nB = has_next ? (const char*)g.Bt + (size_t)S.b_tile(nxt) * tstepB : cB;
        if constexpr (GATHER) nA = cA; else nA = has_next ? (const char*)g.A + (size_t)S.a_tile(nxt) * tstepA : cA;
#pragma unroll 1
        for (int t = 0; t < nt; t += 2) {
            const bool last = (t == nt - 2);
            const char* a1 = cA + (size_t)(t + 1) * kstep;
            const char* a2 = last ? nA : cA + (size_t)(t + 2) * kstep; const char* b2 = last ? nB : cB + (size_t)(t + 2) * kstep;
            const char* a3 = a2 + kstep; const char* b3 = b2 + kstep;
            unsigned t1v[2] = {vA1[0], vA1[1]};
            if constexpr (GATHER) {
                if (last && has_next) {
                    asm volatile("" ::: "memory");
                    const LAS int* tb = gtab + (ui + 1) * 256;
#pragma unroll
                    for (int i = 0; i < 2; ++i) { int R, C; stage_rc(tid * 16 + i * 8192, R, C); int t0 = tb[R], t1 = tb[HALF + R]; t0 = t0 < 0 ? 0 : t0; t1 = t1 < 0 ? 0 : t1;
                        vA0[i] = (unsigned)(t0 * lda + C) * 2u; t1v[i] = (unsigned)(t1 * lda + C) * 2u; }
                    asm volatile("s_waitcnt lgkmcnt(0)" ::: "memory");
                }
            }
            PG8_LDB(B0, 0, 0); PG8_SCHED; PG8_LDA(At, 0, 0); PG8_STAGE(PG8_SA(1, 1), a1, vA1);
            if constexpr (GATHER) { vA1[0] = t1v[0]; vA1[1] = t1v[1]; }
            PG8_WAIT_L(8); PG8_BAR; PG8_WAIT_L(0); PG8_MMA(0, 0, At, B0); PG8_BAR; PG8_SCHED;
            PG8_LDB(B1, 0, 1); PG8_STAGE(PG8_SB(0, 0), b2, voffB);
            PG8_BAR; PG8_WAIT_L(0); PG8_MMA(0, 1, At, B1); PG8_BAR;
            PG8_LDA(At, 0, 1); PG8_STAGE(PG8_SA(0, 0), a2, vA0);
            PG8_BAR; PG8_WAIT_L(0); PG8_MMA(1, 0, At, B0); PG8_BAR; PG8_SCHED;
            PG8_STAGE(PG8_SB(0, 1), b2 + hstep, voffB);
            PG8_WAIT_V(6); PG8_BAR; PG8_MMA(1, 1, At, B1); PG8_BAR;
            PG8_LDB(B0, 1, 0); PG8_SCHED; PG8_LDA(At, 1, 0); PG8_STAGE(PG8_SA(0, 1), a2, vA1);
            PG8_WAIT_L(8); PG8_BAR; PG8_WAIT_L(0); PG8_MMA(0, 0, At, B0); PG8_BAR; PG8_SCHED;
            PG8_LDB(B1, 1, 1); PG8_STAGE(PG8_SB(1, 0), b3, voffB);
            PG8_BAR; PG8_WAIT_L(0); PG8_MMA(0, 1, At, B1); PG8_BAR;
            PG8_LDA(At, 1, 1); PG8_STAGE(PG8_SA(1, 0), a3, vA0);
            PG8_BAR; PG8_WAIT_L(0); PG8_MMA(1, 0, At, B0); PG8_BAR; PG8_SCHED;
            PG8_STAGE(PG8_SB(1, 1), b3 + hstep, voffB);
            PG8_WAIT_V(6); PG8_BAR; PG8_MMA(1, 1, At, B1); PG8_BAR;
        }
        E(acc, cur, wr, wc, fr, fq);
        if (!has_next) break;
#pragma unroll
        for (int a = 0; a < 2; ++a)
#pragma unroll
            for (int b = 0; b < 2; ++b)
#pragma unroll
                for (int m = 0; m < 4; ++m)
#pragma unroll
                    for (int n = 0; n < 2; ++n) acc[a][b][m][n] = (f32x4){0.f, 0.f, 0.f, 0.f};
        cur = nxt; cA = nA; cB = nB; ++ui;
    }
    PG8_WAIT_V(0);
    if (wr == 0) PG8_BAR;
    PG8_BAR;
#undef PG8_SA
#undef PG8_SB
#undef PG8_STAGE
#undef PG8_LDA
#undef PG8_LDB
#undef PG8_MMA
#undef PG8_WAIT_V
#undef PG8_WAIT_L
#undef PG8_BAR
#undef PG8_SCHED
}

typedef const f32x4 (&AccRef)[2][2][4][2];

struct EpiCols {
    static constexpr bool PERM = true;
    bf16 *cr, *cd, *cm, *ch; const float *cosd, *sind, *cosm, *sinm;
    __device__ __forceinline__ void operator()(AccRef acc, const Unit& u, int wr, int wc, int fr, int fq) const {
        const int pn = u.pn; bf16* base; int ldc, colt;
        if (pn < 4) { base = cr; ldc = 1024; colt = pn * 256; } else if (pn < 7) { base = cd; ldc = 768; colt = (pn - 4) * 256; }
        else if (pn < 9) { base = cm; ldc = 512; colt = (pn - 7) * 256; } else { base = ch; ldc = 1024; colt = (pn - 9) * 256; }
        const int row0 = u.pm * BM + wr * 64 + fr;
        const bool rope_d = (pn == 4 || pn == 5);
#pragma unroll
        for (int ai = 0; ai < 2; ++ai)
#pragma unroll
            for (int m = 0; m < 4; ++m) { const int row = row0 + ai * HALF + m * 16;
#pragma unroll
                for (int bj = 0; bj < 2; ++bj) { const int cl = bj * HALF + wc * 32 + 8 * fq;
                    f32x4 v0 = acc[ai][bj][m][0], v1 = acc[ai][bj][m][1];
                    if (rope_d) { const int j0 = ((cl & 63) >> 3) * 4;
                        const f32x4 c = *(const f32x4*)(cosd + (size_t)row * 32 + j0), s = *(const f32x4*)(sind + (size_t)row * 32 + j0);
                        const f32x4 a = v0 * c - v1 * s, b = v1 * c + v0 * s; v0 = a; v1 = b; }
                    else if (pn == 8 && cl >= 128 && cl < 160) { const int j0 = ((cl - 128) >> 3) * 4;
                        const f32x4 c = *(const f32x4*)(cosm + (size_t)row * 16 + j0), s = *(const f32x4*)(sinm + (size_t)row * 16 + j0);
                        const f32x4 a = v0 * c - v1 * s, b = v1 * c + v0 * s; v0 = a; v1 = b; }
                    v4u w; w.x = cvt_pk_bf16(v0[0], v0[1]); w.y = cvt_pk_bf16(v0[2], v0[3]); w.z = cvt_pk_bf16(v1[0], v1[1]); w.w = cvt_pk_bf16(v1[2], v1[3]);
                    *(v4u*)(base + (size_t)row * ldc + colt + cl) = w; } }
    }
};
struct EpiLora {
    static constexpr bool PERM = true;
    bf16* O; const float *w0, *a0;
    __device__ __forceinline__ void operator()(AccRef acc, const Unit& u, int wr, int wc, int fr, int fq) const {
        const int row0 = u.pm * BM + wr * 64 + fr; const int colt = u.pn * BM;
        const float* bias = u.pn == 0 ? w0 : (u.pn == 1 ? a0 : nullptr);
#pragma unroll
        for (int bj = 0; bj < 2; ++bj) { const int cl = bj * HALF + wc * 32 + 8 * fq;
            f32x4 b0 = (f32x4){0.f, 0.f, 0.f, 0.f}, b1 = b0; if (bias) { b0 = *(const f32x4*)(bias + cl); b1 = *(const f32x4*)(bias + cl + 4); }
#pragma unroll
            for (int ai = 0; ai < 2; ++ai)
#pragma unroll
                for (int m = 0; m < 4; ++m) { const int row = row0 + ai * HALF + m * 16;
                    const f32x4 v0 = acc[ai][bj][m][0] + b0, v1 = acc[ai][bj][m][1] + b1;
                    v4u w; w.x = cvt_pk_bf16(v0[0], v0[1]); w.y = cvt_pk_bf16(v0[2], v0[3]); w.z = cvt_pk_bf16(v1[0], v1[1]); w.w = cvt_pk_bf16(v1[2], v1[3]);
                    *(v4u*)(O + (size_t)row * 768 + colt + cl) = w; } }
    }
};
struct EpiMla {
    static constexpr bool PERM = true;
    bf16 *QM, *KVM; const float* rs; const float *cosm, *sinm;
    __device__ __forceinline__ void operator()(AccRef acc, const Unit& u, int wr, int wc, int fr, int fq) const {
        const int row0 = u.pm * BM + wr * 64 + fr;
#pragma unroll
        for (int ai = 0; ai < 2; ++ai)
#pragma unroll
            for (int m = 0; m < 4; ++m) { const int row = row0 + ai * HALF + m * 16;
                const f32x2 sc = *(const f32x2*)(rs + (size_t)row * 2);
#pragma unroll
                for (int bj = 0; bj < 2; ++bj) { const int c = u.pn * BM + bj * HALF + wc * 32 + 8 * fq;
                    if (c >= 896) continue;
                    f32x4 v0 = acc[ai][bj][m][0], v1 = acc[ai][bj][m][1];
                    bf16* dst;
                    if (c < 384) { v0 = v0 * sc.x; v1 = v1 * sc.x; const int pos = c % 96;
                        if (pos >= 64) { const int j0 = ((pos - 64) >> 3) * 4;
                            const f32x4 cc = *(const f32x4*)(cosm + (size_t)row * 16 + j0), ss = *(const f32x4*)(sinm + (size_t)row * 16 + j0);
                            const f32x4 a = v0 * cc - v1 * ss, b = v1 * cc + v0 * ss; v0 = a; v1 = b; }
                        dst = QM + (size_t)row * 384 + c; }
                    else { v0 = v0 * sc.y; v1 = v1 * sc.y; dst = KVM + (size_t)row * 512 + (c - 384); }
                    v4u w; w.x = cvt_pk_bf16(v0[0], v0[1]); w.y = cvt_pk_bf16(v0[2], v0[3]); w.z = cvt_pk_bf16(v1[0], v1[1]); w.w = cvt_pk_bf16(v1[2], v1[3]);
                    *(v4u*)dst = w; } }
    }
};
struct EpiResid {
    static constexpr bool PERM = false;
    const float* res; float* out;
    __device__ __forceinline__ void operator()(AccRef acc, const Unit& u, int wr, int wc, int fr, int fq) const {
        const int row0 = u.pm * BM + wr * 64 + fr, col0 = u.pn * BM + wc * 32 + 4 * fq;
#pragma unroll
        for (int ai = 0; ai < 2; ++ai)
#pragma unroll
            for (int m = 0; m < 4; ++m) { const size_t ro = (size_t)(row0 + ai * HALF + m * 16) * 1024 + col0;
#pragma unroll
                for (int bj = 0; bj < 2; ++bj)
#pragma unroll
                    for (int n = 0; n < 2; ++n) { const size_t o = ro + bj * HALF + n * 16; *(f32x4*)(out + o) = *(const f32x4*)(res + o) + acc[ai][bj][m][n]; } }
    }
};
struct EpiSwiglu {
    static constexpr bool PERM = true;
    bf16* O; int ldc;
    __device__ __forceinline__ void operator()(AccRef acc, const Unit& u, int wr, int wc, int fr, int fq) const {
        const int row0 = u.pm * BM + wr * 64 + fr, col0 = u.pn * HALF + wc * 32 + 8 * fq;
#pragma unroll
        for (int ai = 0; ai < 2; ++ai)
#pragma unroll
            for (int m = 0; m < 4; ++m) { const int row = row0 + ai * HALF + m * 16;
                float r[8];
#pragma unroll
                for (int n = 0; n < 2; ++n)
#pragma unroll
                    for (int j = 0; j < 4; ++j) { const float gte = acc[ai][0][m][n][j], up = acc[ai][1][m][n][j]; r[n * 4 + j] = gte * frcp(1.0f + fexp(-gte)) * up; }
                v4u w; w.x = cvt_pk_bf16(r[0], r[1]); w.y = cvt_pk_bf16(r[2], r[3]); w.z = cvt_pk_bf16(r[4], r[5]); w.w = cvt_pk_bf16(r[6], r[7]);
                *(v4u*)(O + (size_t)row * ldc + col0) = w; }
    }
};
struct EpiMoeDown {
    static constexpr bool PERM = false;
    float* x; const int* rtok; const float* rgate;
    __device__ __forceinline__ void operator()(AccRef acc, const Unit& u, int wr, int wc, int fr, int fq) const {
        const int row0 = u.pm * BM + wr * 64 + fr, col0 = u.pn * BM + wc * 32 + 4 * fq;
#pragma unroll
        for (int ai = 0; ai < 2; ++ai)
#pragma unroll
            for (int m = 0; m < 4; ++m) { const int row = row0 + ai * HALF + m * 16; const int tok = rtok[row]; const float gt = rgate[row];
                if (tok >= 0) { float* rp = x + (size_t)tok * 1024 + col0;
#pragma unroll
                    for (int bj = 0; bj < 2; ++bj)
#pragma unroll
                        for (int n = 0; n < 2; ++n) { float* p = rp + bj * HALF + n * 16; *(f32x4*)p = *(const f32x4*)p + acc[ai][bj][m][n] * gt; } } }
    }
};
}

struct Args { const float* in[31]; float* out; unsigned char* ws; int ph_lo, ph_hi; };
enum { I_X = 0, I_POS, I_MIXN, I_WIN, I_WOUT, I_MU, I_W0, I_W2, I_A0, I_A2, I_G2, I_KK, I_KA, I_RK, I_LNW, I_LNB, I_QN, I_WUQ, I_KVN, I_WUKV, I_LB, I_GN, I_FFNN, I_F1, I_F3, I_F2, I_RT, I_M1, I_M3, I_M2, I_FN };

struct Frame {
    LAS unsigned char* lds; volatile LAS unsigned* MISC; unsigned* ctl;
    int tid, lane, wave, vcu, G;
    unsigned char* ws;
};

template <class Map>
__device__ __forceinline__ void tr_item(const Map& mp, int K, bf16* dst, LAS float* scr, int item, int nblk, int lane) {
    const int kb = item / nblk, nb = item % nblk, k0 = 64 * kb, n0 = 32 * nb;
    const float* colp = mp.col(n0 + (lane & 31)); const size_t ld = mp.ld;
#pragma unroll 8
    for (int i = 0; i < 32; ++i) { const int kk = 2 * i + (lane >> 5); scr[kk * 33 + (lane & 31)] = colp ? colp[(size_t)(k0 + kk) * ld] : 0.f; }
    LDS_WAIT(); asm volatile("" ::: "memory");
    const int c = lane & 7;
#pragma unroll
    for (int j = 0; j < 4; ++j) { const int n = (lane >> 3) + 8 * j; const LAS float* s = scr + (8 * c) * 33 + n;
        v4u o; o.x = pk2(s[0 * 33], s[1 * 33]); o.y = pk2(s[2 * 33], s[3 * 33]); o.z = pk2(s[4 * 33], s[5 * 33]); o.w = pk2(s[6 * 33], s[7 * 33]);
        *(v4u*)(dst + (size_t)(n0 + n) * K + k0 + 8 * c) = o; }
    LDS_WAIT(); asm volatile("" ::: "memory");
}
__device__ __forceinline__ int rope_src_dim(int p, int half) { const int g8 = p >> 3, w = p & 7; return (w < 4) ? (4 * g8 + w) : (half + 4 * g8 + (w - 4)); }
struct MapWin { const float* W; size_t ld;
    __device__ __forceinline__ const float* col(int n) const {
        if (n < 1024) return W + n;
        if (n < 1792) { const int q = n - 1024, part = q >> 8, head = (q & 255) >> 6, pos = q & 63; const int dim = (part < 2) ? rope_src_dim(pos, 32) : pos; return W + 1024 + part * 256 + head * 64 + dim; }
        if (n < 2304) { const int q = n - 1792; if (q < 384) return W + 1792 + q; if (q < 416) return W + 2176 + rope_src_dim(q - 384, 16); return nullptr; }
        return W + 2208 + (n - 2304);
    } };
struct MapId { const float* W; size_t ld; __device__ __forceinline__ const float* col(int n) const { return W + n; } };
struct MapW13 { const float *W1, *W3; size_t ld;
    __device__ __forceinline__ const float* col(int n) const { const int tile = n >> 8, w = n & 255; return (w < 128) ? (W1 + tile * 128 + w) : (W3 + tile * 128 + (w - 128)); } };

template <class Map>
__device__ __forceinline__ void tr_matrix(Frame& F, const Map& mp, int K, int N, bf16* dst) {
    LAS float* scr = (LAS float*)(F.lds + F.wave * 16384);
    const int gw = F.vcu * NWAVES + F.wave, NGW = F.G * NWAVES, nblk = N / 32, nitems = (K / 64) * nblk;
    for (int it = gw; it < nitems; it += NGW) tr_item(mp, K, dst, scr, it, nblk, F.lane);
}

__device__ __forceinline__ void p_prologue(Frame& F, const Args& a) {
    unsigned char* ws = F.ws;
    for (int L = 0; L < DEPTH; ++L) {
        { MapWin mp{a.in[I_WIN] + (size_t)L * D * NIN, (size_t)NIN}; tr_matrix(F, mp, D, NINP, (bf16*)(ws + WS_WIN) + (size_t)L * NINP * D); }
        { MapId mp{a.in[I_WOUT] + (size_t)L * D * D, (size_t)D}; tr_matrix(F, mp, D, D, (bf16*)(ws + WS_WOUT) + (size_t)L * D * D); }
    }
    { MapW13 mp{a.in[I_F1], a.in[I_F3], (size_t)FF}; tr_matrix(F, mp, D, 2 * FF, (bf16*)(ws + WS_W13D)); }
    { MapId mp{a.in[I_F2], (size_t)D}; tr_matrix(F, mp, FF, D, (bf16*)(ws + WS_W2D)); }
    const int gt = F.vcu * (NWAVES * 64) + F.tid, NGT = F.G * NWAVES * 64;
    for (int i = gt; i < DEPTH * 768 * 256; i += NGT) { const int L = i / (768 * 256), r = i % (768 * 256), n = r / 256, k = r % 256; float v = 0.f;
        if (n < 256) { if (k < 64) v = a.in[I_W2][(size_t)L * 64 * 256 + k * 256 + n]; }
        else if (n < 512) { if (k >= 64 && k < 128) v = a.in[I_A2][(size_t)L * 64 * 256 + (k - 64) * 256 + (n - 256)]; }
        else { if (k >= 128) v = a.in[I_G2][(size_t)L * 128 * 256 + (k - 128) * 256 + (n - 512)]; }
        ((bf16*)(ws + WS_WLORA))[i] = (bf16)f2bf(v); }
    for (int i = gt; i < DEPTH * 1024 * 384; i += NGT) { const int L = i / (1024 * 384), r = i % (1024 * 384), n = r / 384, k = r % 384; float v = 0.f;
        if (n < 384) { if (k < 256) { const int head = n / 96, pos = n % 96; const int sc = (pos < 64) ? pos : 64 + rope_src_dim(pos - 64, 16);
                v = a.in[I_QN][L * 256 + k] * a.in[I_WUQ][(size_t)L * 256 * 384 + (size_t)k * 384 + head * 96 + sc]; } }
        else if (n < 896) { if (k >= 256) v = a.in[I_KVN][L * 128 + (k - 256)] * a.in[I_WUKV][(size_t)L * 128 * 512 + (size_t)(k - 256) * 512 + (n - 384)]; }
        ((bf16*)(ws + WS_WMLA))[i] = (bf16)f2bf(v); }
    float* cosd = (float*)(ws + WS_ROPE); float* sind = cosd + (size_t)M * 32; float* cosm = sind + (size_t)M * 32; float* sinm = cosm + (size_t)M * 16;
    const int* pos = (const int*)a.in[I_POS];
    for (int i = gt; i < M * 48; i += NGT) { const int row = i / 48, j = i % 48; const bool dd = j < 32; const int jj = dd ? j : j - 32;
        const float invf = __builtin_amdgcn_exp2f(-(float)jj * (dd ? (13.287712379549449f / 32.0f) : (13.287712379549449f / 16.0f)));
        const double ang = (double)pos[row] * (double)invf; double rev = ang * 0.15915494309189535; rev -= __builtin_rint(rev);
        const float fr = (float)rev; const float s = __builtin_amdgcn_sinf(fr), c = __builtin_amdgcn_cosf(fr);
        if (dd) { cosd[(size_t)row * 32 + jj] = c; sind[(size_t)row * 32 + jj] = s; } else { cosm[(size_t)row * 16 + jj] = c; sinm[(size_t)row * 16 + jj] = s; } }
}
__device__ __forceinline__ void p_moe_weights(Frame& F, const Args& a) {
    for (int e = 0; e < NEXP; ++e) {
        { MapW13 mp{a.in[I_M1] + (size_t)e * D * FFE, a.in[I_M3] + (size_t)e * D * FFE, (size_t)FFE}; tr_matrix(F, mp, D, 2 * FFE, (bf16*)(F.ws + WS_WM13) + (size_t)e * 2 * FFE * D); }
        { MapId mp{a.in[I_M2] + (size_t)e * FFE * D, (size_t)D}; tr_matrix(F, mp, FFE, D, (bf16*)(F.ws + WS_WM2) + (size_t)e * D * FFE); }
    }
}

__device__ __forceinline__ void norm_rows(Frame& F, const float* x, const float* gain, bf16* h) {
    const int gw = F.vcu * NWAVES + F.wave, NGW = F.G * NWAVES;
    f32x4 gv[4];
#pragma unroll
    for (int j = 0; j < 4; ++j) gv[j] = *(const f32x4*)(gain + 4 * F.lane + 256 * j);
    for (int m = gw; m < M; m += NGW) {
        const f32x4* xr = (const f32x4*)(x + (size_t)m * D) + F.lane; f32x4 v[4]; float s = 0.f;
#pragma unroll
        for (int j = 0; j < 4; ++j) { v[j] = xr[64 * j]; s += (v[j].x * v[j].x + v[j].y * v[j].y) + (v[j].z * v[j].z + v[j].w * v[j].w); }
        const float r = __builtin_amdgcn_rsqf(wave_sum(s) * (1.f / D) + 1e-6f);
        v2u* o = (v2u*)(h + (size_t)m * D) + F.lane;
#pragma unroll
        for (int j = 0; j < 4; ++j) { const f32x4 y = v[j] * r * gv[j]; v2u w; w.x = pk2(y.x, y.y); w.y = pk2(y.z, y.w); o[64 * j] = w; }
    }
}
__device__ __forceinline__ void final_norm_rows(Frame& F, float* x, const float* gain) {
    const int gw = F.vcu * NWAVES + F.wave, NGW = F.G * NWAVES;
    f32x4 gv[4];
#pragma unroll
    for (int j = 0; j < 4; ++j) gv[j] = *(const f32x4*)(gain + 4 * F.lane + 256 * j);
    for (int m = gw; m < M; m += NGW) {
        f32x4* xr = (f32x4*)(x + (size_t)m * D) + F.lane; f32x4 v[4]; float s = 0.f;
#pragma unroll
        for (int j = 0; j < 4; ++j) { v[j] = xr[64 * j]; s += (v[j].x * v[j].x + v[j].y * v[j].y) + (v[j].z * v[j].z + v[j].w * v[j].w); }
        const float r = __builtin_amdgcn_rsqf(wave_sum(s) * (1.f / D) + 1e-6f);
#pragma unroll
        for (int j = 0; j < 4; ++j) xr[64 * j] = v[j] * r * gv[j];
    }
}
__device__ __forceinline__ void norm_router(Frame& F, const float* x, const float* gain, const float* wr, bf16* h) {
    LAS float* wl = (LAS float*)F.lds;
    LAS int* lcnt = (LAS int*)(F.lds + 32768);
    LAS int* lbase = lcnt + 16;
    LAS int* lrow = lcnt + 32;
    for (int i = F.tid; i < 8192; i += 512) wl[i] = wr[i];
    if (F.tid < 16) lcnt[F.tid] = 0;
    int* rtok = (int*)(F.ws + MS_RTOK); const int gt = F.vcu * 512 + F.tid;
    for (int i = gt; i < 2 * MAXROWS; i += F.G * 512) rtok[i] = -1;
    __syncthreads();
    f32x4 gv[4];
#pragma unroll
    for (int j = 0; j < 4; ++j) gv[j] = *(const f32x4*)(gain + 4 * F.lane + 256 * j);
    int* tope = (int*)(F.ws + MS_TOPE); float* gate = (float*)(F.ws + MS_GATE); int* rank = (int*)(F.ws + MS_RANK);
    const int rb = blockIdx.x * 128;
    for (int q = 0; q < 16; ++q) { const int lr = F.wave * 16 + q, m = rb + lr;
        const f32x4* xr = (const f32x4*)(x + (size_t)m * D) + F.lane; f32x4 v[4]; float s = 0.f;
#pragma unroll
        for (int j = 0; j < 4; ++j) { v[j] = xr[64 * j]; s += (v[j].x * v[j].x + v[j].y * v[j].y) + (v[j].z * v[j].z + v[j].w * v[j].w); }
        const float r = __builtin_amdgcn_rsqf(wave_sum(s) * (1.f / D) + 1e-6f);
        float lg[8];
#pragma unroll
        for (int e = 0; e < 8; ++e) lg[e] = 0.f;
        v2u* o = (v2u*)(h + (size_t)m * D) + F.lane;
#pragma unroll
        for (int j = 0; j < 4; ++j) { const f32x4 y = v[j] * r * gv[j]; v2u w; w.x = pk2(y.x, y.y); w.y = pk2(y.z, y.w); o[64 * j] = w;
#pragma unroll
            for (int c = 0; c < 4; ++c) { const int k = 4 * F.lane + 256 * j + c; const f32x4 wa = *(const LAS f32x4*)(wl + k * 8), wb = *(const LAS f32x4*)(wl + k * 8 + 4);
                lg[0] += y[c] * wa.x; lg[1] += y[c] * wa.y; lg[2] += y[c] * wa.z; lg[3] += y[c] * wa.w; lg[4] += y[c] * wb.x; lg[5] += y[c] * wb.y; lg[6] += y[c] * wb.z; lg[7] += y[c] * wb.w; } }
#pragma unroll
        for (int e = 0; e < 8; ++e) lg[e] = wave_sum(lg[e]);
        int e0 = 0; float v0 = lg[0];
#pragma unroll
        for (int e = 1; e < 8; ++e) if (lg[e] > v0) { v0 = lg[e]; e0 = e; }
        int e1 = -1; float v1 = -3.0e38f;
#pragma unroll
        for (int e = 0; e < 8; ++e) if (e != e0 && lg[e] > v1) { v1 = lg[e]; e1 = e; }
        if (F.lane == 0) { const float g1 = frcp(1.0f + fexp(v0 - v1)); const float g0 = 1.0f - g1;
            const int r0 = atomicAdd((int*)&lcnt[e0], 1), r1 = atomicAdd((int*)&lcnt[8 + e1], 1);
            lrow[lr * 4 + 0] = e0; lrow[lr * 4 + 1] = e1; lrow[lr * 4 + 2] = r0; lrow[lr * 4 + 3] = r1;
            tope[m * 2] = e0; tope[m * 2 + 1] = e1; gate[m * 2] = g0; gate[m * 2 + 1] = g1; }
    }
    __syncthreads();
    if (F.tid < 16) lbase[F.tid] = (int)atomicAdd(F.ctl + CW_CNT + F.tid, (unsigned)lcnt[F.tid]);
    __syncthreads();
    if (F.tid < 128) { const int m = rb + F.tid; rank[m * 2] = lbase[lrow[F.tid * 4]] + lrow[F.tid * 4 + 2]; rank[m * 2 + 1] = lbase[8 + lrow[F.tid * 4 + 1]] + lrow[F.tid * 4 + 3]; }
    __syncthreads();
}
__device__ __forceinline__ int moe_tables(Frame& F, int s, LAS int* tstart, LAS int* texp) {
    __syncthreads();
    if (F.tid == 0) { int acc = 0;
        for (int e = 0; e < 8; ++e) { const int c = (int)__hip_atomic_load(F.ctl + CW_CNT + s * 8 + e, __ATOMIC_RELAXED, __HIP_MEMORY_SCOPE_AGENT); const int nt = (c + 255) >> 8; tstart[e] = acc;
            for (int t = 0; t < nt && acc + t < MAXT; ++t) texp[acc + t] = e; acc += nt; }
        tstart[8] = acc > MAXT ? MAXT : acc; }
    __syncthreads();
    return tstart[8];
}
__device__ __forceinline__ void moe_scatter(Frame& F) {
    LAS int* tst = (LAS int*)(F.lds + 1024); LAS int* texp = (LAS int*)(F.lds + 2048);
    const int* tope = (const int*)(F.ws + MS_TOPE); const float* gate = (const float*)(F.ws + MS_GATE); const int* rank = (const int*)(F.ws + MS_RANK);
    int* rtok = (int*)(F.ws + MS_RTOK); float* rgate = (float*)(F.ws + MS_RGATE);
    int st0[8], st1[8];
    moe_tables(F, 0, tst, texp);
#pragma unroll
    for (int e = 0; e < 8; ++e) st0[e] = tst[e];
    moe_tables(F, 1, tst, texp);
#pragma unroll
    for (int e = 0; e < 8; ++e) st1[e] = tst[e];
    const int gt = F.vcu * 512 + F.tid;
    for (int m = gt; m < M; m += F.G * 512) {
        const int e0 = tope[m * 2], e1 = tope[m * 2 + 1];
        int b0 = 0, b1 = 0;
#pragma unroll
        for (int e = 0; e < 8; ++e) { b0 = (e == e0) ? st0[e] : b0; b1 = (e == e1) ? st1[e] : b1; }
        const int p0 = b0 * 256 + rank[m * 2], p1 = b1 * 256 + rank[m * 2 + 1];
        if (p0 < MAXROWS) { rtok[p0] = m; rgate[p0] = gate[m * 2]; }
        if (p1 < MAXROWS) { rtok[MAXROWS + p1] = m; rgate[MAXROWS + p1] = gate[m * 2 + 1]; }
    }
}

__device__ __forceinline__ void p_prepA(Frame& F, const Args& a, int L) {
    const bf16* cr = (const bf16*)(F.ws + WS_CR); const bf16* cm = (const bf16*)(F.ws + WS_CM);
    bf16* al = (bf16*)(F.ws + WS_AL); float* rs = (float*)(F.ws + MS_RS);
    const float* mu = a.in[I_MU] + L * 1024 + 768;
    const int gw = F.vcu * NWAVES + F.wave, NGW = F.G * NWAVES;
    f32x4 muv = *(const f32x4*)(mu + 4 * F.lane);
    for (int m = gw; m < M; m += NGW) {
        const int t = m & (T - 1);
        const v2u cw = *(const v2u*)(cr + (size_t)m * 1024 + 768 + 4 * F.lane);
        v2u pw = (v2u){0u, 0u}; if (t > 0) pw = *(const v2u*)(cr + (size_t)(m - 1) * 1024 + 768 + 4 * F.lane);
        float c[4] = {bflo(cw.x), bfhi(cw.x), bflo(cw.y), bfhi(cw.y)}, p[4] = {bflo(pw.x), bfhi(pw.x), bflo(pw.y), bfhi(pw.y)}, o[4];
#pragma unroll
        for (int j = 0; j < 4; ++j) { const float xs = c[j] + (p[j] - c[j]) * muv[j]; const int col = 4 * F.lane + j; o[j] = (col < 64) ? tanhf_(xs) : ((col < 128) ? xs : sigmoidf_(xs)); }
        v2u w; w.x = pk2(o[0], o[1]); w.y = pk2(o[2], o[3]); *(v2u*)(al + (size_t)m * 256 + 4 * F.lane) = w;
        const v2u q = *(const v2u*)(cm + (size_t)m * 512 + 4 * F.lane);
        float sq = bflo(q.x) * bflo(q.x) + bfhi(q.x) * bfhi(q.x) + bflo(q.y) * bflo(q.y) + bfhi(q.y) * bfhi(q.y);
        const unsigned kv = *(const unsigned*)(cm + (size_t)m * 512 + 256 + 2 * F.lane);
        float sk = bflo(kv) * bflo(kv) + bfhi(kv) * bfhi(kv);
        sq = wave_sum(sq); sk = wave_sum(sk);
        if (F.lane == 0) { rs[m * 2] = __builtin_amdgcn_rsqf(sq * (1.f / 256.f) + 1e-6f); rs[m * 2 + 1] = __builtin_amdgcn_rsqf(sk * (1.f / 128.f) + 1e-6f); }
    }
}
__device__ __forceinline__ void p_prepB(Frame& F, const Args& a, int L) {
    const bf16* cr = (const bf16*)(F.ws + WS_CR); const bf16* lo = (const bf16*)(F.ws + WS_LO);
    bf16* opr = (bf16*)(F.ws + WS_OPR); bf16* opk = (bf16*)(F.ws + WS_OPK); bf16* opv = (bf16*)(F.ws + WS_OPV); bf16* opkk = (bf16*)(F.ws + WS_OPKK); bf16* opka = (bf16*)(F.ws + WS_OPKA);
    float* opw = (float*)(F.ws + WS_OPW);
    const float* mu = a.in[I_MU] + L * 1024; const float* kkp = a.in[I_KK] + L * 256; const float* kap = a.in[I_KA] + L * 256;
    const int gw = F.vcu * NWAVES + F.wave, NGW = F.G * NWAVES;
    for (int it = gw; it < M * 4; it += NGW) {
        const int m = it >> 2, hd = it & 3, ch = hd * 64 + F.lane, t = m & (T - 1);
        const size_t ro = (size_t)m * 1024;
        float cr_ = bf2f(cr[ro + ch]), ck = bf2f(cr[ro + 256 + ch]), cv = bf2f(cr[ro + 512 + ch]);
        float pr = 0.f, pk = 0.f, pv = 0.f; if (t > 0) { pr = bf2f(cr[ro - 1024 + ch]); pk = bf2f(cr[ro - 1024 + 256 + ch]); pv = bf2f(cr[ro - 1024 + 512 + ch]); }
        const float r = cr_ + (pr - cr_) * mu[ch], k = ck + (pk - ck) * mu[256 + ch], v = cv + (pv - cv) * mu[512 + ch];
        const float uw = bf2f(lo[(size_t)m * 768 + ch]), ua = bf2f(lo[(size_t)m * 768 + 256 + ch]);
        const float decay = fexp(-0.6065306597126334f * sigmoidf_(uw));
        const float aa = sigmoidf_(ua);
        float kk = k * kkp[ch]; const float nrm = sqrtf(wave_sum(kk * kk)); kk = kk / fmaxf(nrm, 1e-12f);
        const float k2 = k * (1.0f + (aa - 1.0f) * kap[ch]);
        const size_t oo = (size_t)m * 256 + ch;
        opr[oo] = (bf16)f2bf(r); opk[oo] = (bf16)f2bf(k2); opv[oo] = (bf16)f2bf(v); opkk[oo] = (bf16)f2bf(kk); opka[oo] = (bf16)f2bf(kk * aa); opw[oo] = decay;
    }
}
__device__ __forceinline__ void p_post(Frame& F, const Args& a, int L) {
    const bf16* lo = (const bf16*)(F.ws + WS_LO); const bf16* ch_ = (const bf16*)(F.ws + WS_CH);
    const bf16* opr = (const bf16*)(F.ws + WS_OPR); const bf16* opk = (const bf16*)(F.ws + WS_OPK); const bf16* opv = (const bf16*)(F.ws + WS_OPV);
    const float* yra = (const float*)(F.ws + WS_YRA); const float* yrh = (const float*)(F.ws + WS_YRH);
    bf16* y = (bf16*)(F.ws + WS_H);
    const float* rk = a.in[I_RK] + L * 256; const float* lnw = a.in[I_LNW] + L * 256; const float* lnb = a.in[I_LNB] + L * 256; const float* gn = a.in[I_GN] + L * 256;
    const int gw = F.vcu * NWAVES + F.wave, NGW = F.G * NWAVES;
    for (int it = gw; it < M * 4; it += NGW) {
        const int m = it >> 2, hd = it & 3, ch = hd * 64 + F.lane; const size_t oo = (size_t)m * 256 + ch;
        { const float yv = yra[oo]; const float mean = wave_sum(yv) * (1.f / 64.f); const float dv = yv - mean; const float var = wave_sum(dv * dv) * (1.f / 64.f);
          float o = dv * __builtin_amdgcn_rsqf(var + 64e-5f) * lnw[ch] + lnb[ch];
          const float r = bf2f(opr[oo]), k = bf2f(opk[oo]), v = bf2f(opv[oo]);
          const float bon = wave_sum(r * k * rk[ch]) * v;
          const float g = bf2f(lo[(size_t)m * 768 + 512 + ch]);
          y[(size_t)m * 1024 + ch] = (bf16)f2bf((o + bon) * g); }
        { const float ov = yrh[oo]; const float ms = wave_sum(ov * ov) * (1.f / 64.f);
          const float g = bf2f(ch_[(size_t)m * 1024 + 768 + ch]);
          y[(size_t)m * 1024 + 768 + ch] = (bf16)f2bf(ov * __builtin_amdgcn_rsqf(ms + 1e-6f) * gn[ch] * siluf_(g)); }
    }
}

constexpr int SC_TC = 32;
constexpr int SC_RW_BYTES = 5 * SC_TC * 64 * 4 + SC_TC * 16 * 4;
constexpr int SC_HG_BYTES = 2 * SC_TC * 64 * 4 + SC_TC * 16 * 4;
constexpr int SC_BUF = SC_RW_BYTES + SC_HG_BYTES;
constexpr int SC_YOFF = 2 * SC_BUF;
static_assert(SC_YOFF + 2 * SC_TC * 16 * 4 <= RING_BYTES, "scan LDS");
__device__ __forceinline__ void sc_put8(LAS float* dst, v4u q) { *(LAS f32x4*)dst = (f32x4){bflo(q.x), bfhi(q.x), bflo(q.y), bfhi(q.y)}; *(LAS f32x4*)(dst + 4) = (f32x4){bflo(q.z), bfhi(q.z), bflo(q.w), bfhi(q.w)}; }
__device__ __forceinline__ void p_scan(Frame& F, const Args& a, int L) {
    const int v = F.vcu, bh = v >> 2, rq = v & 3, b = bh >> 2, hd = bh & 3;
    const bool rw = F.wave < 4; const int gtid = F.tid & 255;
    const size_t row0 = (size_t)b * T;
    const bf16* opr = (const bf16*)(F.ws + WS_OPR) + row0 * 256 + hd * 64; const bf16* opk = (const bf16*)(F.ws + WS_OPK) + row0 * 256 + hd * 64;
    const bf16* opv = (const bf16*)(F.ws + WS_OPV) + row0 * 256 + hd * 64 + rq * 16; const bf16* opkk = (const bf16*)(F.ws + WS_OPKK) + row0 * 256 + hd * 64;
    const bf16* opka = (const bf16*)(F.ws + WS_OPKA) + row0 * 256 + hd * 64; const float* opw = (const float*)(F.ws + WS_OPW) + row0 * 256 + hd * 64;
    const bf16* chq = (const bf16*)(F.ws + WS_CH) + row0 * 1024 + hd * 64;
    float* yout = (float*)(F.ws + (rw ? WS_YRA : WS_YRH)) + row0 * 256 + hd * 64 + rq * 16;
    const int lr = (F.wave & 3) * 4 + (F.lane >> 4);
    const int kq = F.lane & 15;
    float S0 = 0.f, S1 = 0.f, S2 = 0.f, S3 = 0.f;
    v4u gk = (v4u){0, 0, 0, 0}, gkk = gk, gka = gk, gr = gk, gv = gk; f32x4 gw0 = (f32x4){0, 0, 0, 0}, gw1 = gw0;
    const int st_t = gtid >> 3, st_c = gtid & 7;
    float lb8[8];
#pragma unroll
    for (int j = 0; j < 8; ++j) { lb8[j] = 0.f; if (L == 1) { const int c = hd * 64 + st_c * 8 + j; lb8[j] = sigmoidf_(a.in[I_LB][256 + c] - a.in[I_LB][c]); } }
#define SC_ISSUE(c_) do { const size_t tb = (size_t)((c_) * SC_TC + st_t); \
        if (rw) { gk = *(const v4u*)(opk + tb * 256 + st_c * 8); gkk = *(const v4u*)(opkk + tb * 256 + st_c * 8); gka = *(const v4u*)(opka + tb * 256 + st_c * 8); gr = *(const v4u*)(opr + tb * 256 + st_c * 8); \
            gw0 = *(const f32x4*)(opw + tb * 256 + st_c * 8); gw1 = *(const f32x4*)(opw + tb * 256 + st_c * 8 + 4); \
            if (gtid < 64) gv = *(const v4u*)(opv + (size_t)((c_) * SC_TC + (gtid >> 1)) * 256 + (gtid & 1) * 8); } \
        else { gk = *(const v4u*)(chq + tb * 1024 + st_c * 8); gkk = *(const v4u*)(chq + tb * 1024 + 256 + st_c * 8); \
            if (gtid < 64) gv = *(const v4u*)(chq + (size_t)((c_) * SC_TC + (gtid >> 1)) * 1024 + 512 + rq * 16 + (gtid & 1) * 8); } } while (0)
#define SC_PUT8(dst, val_) sc_put8((dst), (val_))
#define SC_COMMIT(buf_) do { LAS float* cb = (LAS float*)(F.lds + (buf_) * SC_BUF + (rw ? 0 : SC_RW_BYTES)); const int o = st_t * 64 + st_c * 8; \
        if (rw) { *(LAS f32x4*)(cb + o) = gw0; *(LAS f32x4*)(cb + o + 4) = gw1; \
            SC_PUT8(cb + SC_TC * 64 + o, gkk); SC_PUT8(cb + 2 * SC_TC * 64 + o, gka); SC_PUT8(cb + 3 * SC_TC * 64 + o, gk); SC_PUT8(cb + 4 * SC_TC * 64 + o, gr); \
            if (gtid < 64) SC_PUT8(cb + 5 * SC_TC * 64 + (gtid >> 1) * 16 + (gtid & 1) * 8, gv); } \
        else { float fz[8] = {bflo(gkk.x), bfhi(gkk.x), bflo(gkk.y), bfhi(gkk.y), bflo(gkk.z), bfhi(gkk.z), bflo(gkk.w), bfhi(gkk.w)}; \
            float qz[8] = {bflo(gk.x), bfhi(gk.x), bflo(gk.y), bfhi(gk.y), bflo(gk.z), bfhi(gk.z), bflo(gk.w), bfhi(gk.w)}; \
            _Pragma("unroll") for (int j = 0; j < 8; ++j) { fz[j] = lb8[j] + (1.0f - lb8[j]) * sigmoidf_(fz[j]); qz[j] = siluf_(qz[j]); } \
            *(LAS f32x4*)(cb + o) = (f32x4){fz[0], fz[1], fz[2], fz[3]}; *(LAS f32x4*)(cb + o + 4) = (f32x4){fz[4], fz[5], fz[6], fz[7]}; \
            *(LAS f32x4*)(cb + SC_TC * 64 + o) = (f32x4){qz[0], qz[1], qz[2], qz[3]}; *(LAS f32x4*)(cb + SC_TC * 64 + o + 4) = (f32x4){qz[4], qz[5], qz[6], qz[7]}; \
            if (gtid < 64) SC_PUT8(cb + 2 * SC_TC * 64 + (gtid >> 1) * 16 + (gtid & 1) * 8, gv); } } while (0)
    constexpr int NCH = T / SC_TC;
    SC_ISSUE(0); SC_COMMIT(0); __syncthreads();
    LAS float* ybuf = (LAS float*)(F.lds + SC_YOFF) + (rw ? 0 : SC_TC * 16);
    for (int c = 0; c < NCH; ++c) {
        if (c + 1 < NCH) SC_ISSUE(c + 1);
        const LAS float* base = (const LAS float*)(F.lds + (c & 1) * SC_BUF + (rw ? 0 : SC_RW_BYTES));
        if (rw) {
#pragma unroll 4
            for (int t = 0; t < SC_TC; ++t) {
                const f32x4 w4 = *(const LAS f32x4*)(base + t * 64 + kq * 4), kk4 = *(const LAS f32x4*)(base + SC_TC * 64 + t * 64 + kq * 4), ka4 = *(const LAS f32x4*)(base + 2 * SC_TC * 64 + t * 64 + kq * 4);
                const f32x4 k4 = *(const LAS f32x4*)(base + 3 * SC_TC * 64 + t * 64 + kq * 4), r4 = *(const LAS f32x4*)(base + 4 * SC_TC * 64 + t * 64 + kq * 4);
                const float vv = base[5 * SC_TC * 64 + t * 16 + lr];
                float d = S0 * kk4.x + S1 * kk4.y + S2 * kk4.z + S3 * kk4.w; d = row16_sum(d);
                S0 = S0 * w4.x - d * ka4.x + vv * k4.x; S1 = S1 * w4.y - d * ka4.y + vv * k4.y; S2 = S2 * w4.z - d * ka4.z + vv * k4.z; S3 = S3 * w4.w - d * ka4.w + vv * k4.w;
                float yv = S0 * r4.x + S1 * r4.y + S2 * r4.z + S3 * r4.w; yv = row16_sum(yv);
                if (kq == 0) ybuf[t * 16 + lr] = yv;
            }
        } else {
#pragma unroll 4
            for (int t = 0; t < SC_TC; ++t) {
                const f32x4 f4 = *(const LAS f32x4*)(base + t * 64 + kq * 4), q4 = *(const LAS f32x4*)(base + SC_TC * 64 + t * 64 + kq * 4);
                const float vv = base[2 * SC_TC * 64 + t * 16 + lr];
                S0 = f4.x * S0 + (1.0f - f4.x) * vv; S1 = f4.y * S1 + (1.0f - f4.y) * vv; S2 = f4.z * S2 + (1.0f - f4.z) * vv; S3 = f4.w * S3 + (1.0f - f4.w) * vv;
                float yv = S0 * q4.x + S1 * q4.y + S2 * q4.z + S3 * q4.w; yv = row16_sum(yv);
                if (kq == 0) ybuf[t * 16 + lr] = yv;
            }
        }
        if (c + 1 < NCH) SC_COMMIT((c + 1) & 1);
        __syncthreads();
#pragma unroll
        for (int j = 0; j < 2; ++j) { const int idx = gtid + 256 * j, tt = idx >> 4, rr = idx & 15; yout[(size_t)(c * SC_TC + tt) * 256 + rr] = ybuf[idx]; }
        __syncthreads();
    }
#undef SC_ISSUE
#undef SC_PUT8
#undef SC_COMMIT
}

constexpr int AT_KOFF = 0, AT_KB = 64 * 104 * 2, AT_VOFF = AT_KB, AT_VSTR = 68, AT_VB = 64 * AT_VSTR * 2;
__device__ __forceinline__ int crow(int r) { return (r & 3) + 8 * (r >> 2); }
template <int DQ, bool DIL>
__device__ __forceinline__ void attn_unit(Frame& F, const bf16* Qp, int ldq, const bf16* K1, int ldk1, const bf16* K2, int ldk2, const bf16* Vp, int ldv, bf16* Op, int ldo, int q0, float c1) {
    constexpr int KSTR = DQ + 8, NS = DQ / 16;
    const int lane = F.lane, r = lane & 31, h = lane >> 5, wid = F.wave, tid = F.tid;
    LAS bf16* Ks = (LAS bf16*)(F.lds + AT_KOFF); LAS bf16* Vt = (LAS bf16*)(F.lds + AT_VOFF);
    const int qi = q0 + wid * 32 + r;
    bf16x8 qr[NS];
#pragma unroll
    for (int s = 0; s < NS; ++s) qr[s] = *(const bf16x8*)(Qp + (size_t)qi * ldq + 16 * s + 8 * h);
    f32x16 o0, o1;
#pragma unroll
    for (int i = 0; i < 16; ++i) { o0[i] = 0.f; o1[i] = 0.f; }
    float mrun = -1.0e30f, lrun = 0.f;
    const int ntile = (q0 + 256) / 64; const int qhi = q0 + wid * 32 + 31;
    const int skey = tid >> 3, sc = tid & 7, skey2 = tid >> 2, sc2 = tid & 3;
    v4u gk, gk2 = (v4u){0, 0, 0, 0}, gv;
    gk = *(const v4u*)(K1 + (size_t)skey * ldk1 + sc * 8); gv = *(const v4u*)(Vp + (size_t)skey * ldv + sc * 8);
    if (DQ == 96 && tid < 256) gk2 = *(const v4u*)(K2 + (size_t)skey2 * ldk2 + sc2 * 8);
    for (int t = 0; t < ntile; ++t) {
        const int k0 = t * 64;
        __syncthreads();
        *(LAS v4u*)(Ks + skey * KSTR + sc * 8) = gk;
        if (DQ == 96 && tid < 256) *(LAS v4u*)(Ks + skey2 * KSTR + 64 + sc2 * 8) = gk2;
        { const unsigned w[4] = {gv.x, gv.y, gv.z, gv.w};
#pragma unroll
          for (int j = 0; j < 4; ++j) { Vt[(sc * 8 + 2 * j) * AT_VSTR + skey] = (bf16)(w[j] & 0xffffu); Vt[(sc * 8 + 2 * j + 1) * AT_VSTR + skey] = (bf16)(w[j] >> 16); } }
        __syncthreads();
        if (t + 1 < ntile) { const size_t kn = (size_t)(k0 + 64);
            gk = *(const v4u*)(K1 + (kn + skey) * ldk1 + sc * 8); gv = *(const v4u*)(Vp + (kn + skey) * ldv + sc * 8);
            if (DQ == 96 && tid < 256) gk2 = *(const v4u*)(K2 + (kn + skey2) * ldk2 + sc2 * 8); }
        if (k0 > qhi) continue;
        f32x16 p[2];
#pragma unroll
        for (int kb = 0; kb < 2; ++kb) {
#pragma unroll
            for (int i = 0; i < 16; ++i) p[kb][i] = 0.f;
#pragma unroll
            for (int s = 0; s < NS; ++s) { const bf16x8 ka = *(const LAS bf16x8*)(Ks + (kb * 32 + r) * KSTR + 16 * s + 8 * h);
                p[kb] = __builtin_amdgcn_mfma_f32_32x32x16_bf16(ka, qr[s], p[kb], 0, 0, 0); }
        }
        float mx = -INFINITY;
#pragma unroll
        for (int kb = 0; kb < 2; ++kb)
#pragma unroll
            for (int i = 0; i < 16; ++i) { const int dl = qi - (k0 + kb * 32 + crow(i) + 4 * h); float sv = p[kb][i] * c1;
                if (DIL) { const int cnt = (dl <= 128 ? 1 : 0) + (((dl & 3) == 0 && dl <= 512) ? 1 : 0) + (((dl & 15) == 0) ? 1 : 0);
                    const float bias = (cnt == 0) ? -INFINITY : ((cnt == 1) ? 0.f : ((cnt == 2) ? 1.0f : 1.5849625007211562f));
                    sv = (dl < 0) ? -INFINITY : sv + bias; }
                else sv = (dl < 0) ? -INFINITY : sv;
                p[kb][i] = sv; mx = fmaxf(mx, sv); }
        mx = fmaxf(mx, __shfl_xor(mx, 32));
        const float mnew = fmaxf(mrun, mx); const float alpha = __builtin_amdgcn_exp2f(mrun - mnew); mrun = mnew;
        float rsum = 0.f;
#pragma unroll
        for (int kb = 0; kb < 2; ++kb)
#pragma unroll
            for (int i = 0; i < 16; ++i) { const float e = __builtin_amdgcn_exp2f(p[kb][i] - mnew); p[kb][i] = e; rsum += e; }
        lrun = lrun * alpha + rsum;
#pragma unroll
        for (int i = 0; i < 16; ++i) { o0[i] *= alpha; o1[i] *= alpha; }
#pragma unroll
        for (int kb = 0; kb < 2; ++kb)
#pragma unroll
            for (int s2 = 0; s2 < 2; ++s2) {
                v4u pw; pw.x = cvt_pk_bf16(p[kb][8 * s2 + 0], p[kb][8 * s2 + 1]); pw.y = cvt_pk_bf16(p[kb][8 * s2 + 2], p[kb][8 * s2 + 3]);
                pw.z = cvt_pk_bf16(p[kb][8 * s2 + 4], p[kb][8 * s2 + 5]); pw.w = cvt_pk_bf16(p[kb][8 * s2 + 6], p[kb][8 * s2 + 7]);
                const bf16x8 pb = __builtin_bit_cast(bf16x8, pw);
                const int kc = kb * 32 + 16 * s2 + 4 * h;
                { const v2u a0 = *(const LAS v2u*)(Vt + r * AT_VSTR + kc), a1 = *(const LAS v2u*)(Vt + r * AT_VSTR + kc + 8);
                  const v4u av = (v4u){a0.x, a0.y, a1.x, a1.y}; o0 = __builtin_amdgcn_mfma_f32_32x32x16_bf16(__builtin_bit_cast(bf16x8, av), pb, o0, 0, 0, 0); }
                { const v2u a0 = *(const LAS v2u*)(Vt + (32 + r) * AT_VSTR + kc), a1 = *(const LAS v2u*)(Vt + (32 + r) * AT_VSTR + kc + 8);
                  const v4u av = (v4u){a0.x, a0.y, a1.x, a1.y}; o1 = __builtin_amdgcn_mfma_f32_32x32x16_bf16(__builtin_bit_cast(bf16x8, av), pb, o1, 0, 0, 0); }
            }
    }
    lrun += __shfl_xor(lrun, 32);
    const float inv = frcp(lrun);
    bf16* orow = Op + (size_t)qi * ldo;
#pragma unroll
    for (int g = 0; g < 4; ++g) {
        v2u w0, w1; w0.x = pk2(o0[4 * g] * inv, o0[4 * g + 1] * inv); w0.y = pk2(o0[4 * g + 2] * inv, o0[4 * g + 3] * inv);
        w1.x = pk2(o1[4 * g] * inv, o1[4 * g + 1] * inv); w1.y = pk2(o1[4 * g + 2] * inv, o1[4 * g + 3] * inv);
        *(v2u*)(orow + 8 * g + 4 * h) = w0; *(v2u*)(orow + 32 + 8 * g + 4 * h) = w1;
    }
    __syncthreads();
}
__device__ __forceinline__ void p_attn(Frame& F) {
    const int v = F.vcu, bh = v >> 2, s = v & 3, b = bh >> 2, hd = bh & 3; const size_t row0 = (size_t)b * T;
    const bf16* cd = (const bf16*)(F.ws + WS_CD) + row0 * 768 + hd * 64; const bf16* cm = (const bf16*)(F.ws + WS_CM) + row0 * 512 + 384;
    const bf16* qm = (const bf16*)(F.ws + WS_QM) + row0 * 384 + hd * 96; const bf16* kvm = (const bf16*)(F.ws + WS_KVM) + row0 * 512 + hd * 128;
    bf16* y = (bf16*)(F.ws + WS_H) + row0 * 1024;
    for (int i = 0; i < 2; ++i) { const int qb = i == 0 ? s : 7 - s;
        attn_unit<64, true>(F, cd, 768, cd + 256, 768, nullptr, 0, cd + 512, 768, y + 256 + hd * 64, 1024, qb * 256, 0.125f * 1.4426950408889634f);
        attn_unit<96, false>(F, qm, 384, kvm, 512, cm, 512, kvm + 64, 512, y + 512 + hd * 64, 1024, qb * 256, 0.10206207261596577f * 1.4426950408889634f); }
}

constexpr int PH_PRO = 0, PH_L = 12, PH_MOE = 1 + 2 * PH_L - 2;
constexpr int PH_SCAT = 23, PH_UP0 = 24, PH_DN0 = 25, PH_UP1 = 26, PH_DN1 = 27, PH_FIN = 28, N_PHASES = 29;

template <int CLS>
__global__ void __launch_bounds__(NWAVES * 64, 2) mega_fwd(Args args) {
    extern __shared__ __attribute__((aligned(16))) unsigned char lds[];
    Frame F;
    F.lds = (LAS unsigned char*)lds; F.MISC = (volatile LAS unsigned*)(F.lds + MISC_OFF);
    F.tid = threadIdx.x; F.lane = F.tid & 63; F.wave = __builtin_amdgcn_readfirstlane(F.tid >> 6);
    F.G = gridDim.x; { const int bx = blockIdx.x; F.vcu = (F.G % 8 == 0) ? (bx % 8) * (F.G / 8) + bx / 8 : bx; }
    F.ws = args.ws; F.ctl = (unsigned*)(args.ws + WS_CTL);
    for (int u = F.tid; u < 256; u += NWAVES * 64) ((LAS unsigned*)(F.lds + MISC_OFF))[u] = 0u;
    __syncthreads();
    XcdBarrier bar; bar.bar = F.ctl + CW_BAR; bar.x = 0; bar.st = nullptr;
#if MK_ONE_LAUNCH
    bar = xcd_barrier_post(F.ctl + CW_BAR, F.MISC + 8);
#define GRID_BAR() xcd_barrier(bar)
#else
#define GRID_BAR() do { } while (0)
#endif
    const int lo = args.ph_lo, hi = args.ph_hi;
#define IN(k) (lo <= (k) && (k) < hi)
#define SEAM(k) do { if (IN(k) && IN((k) + 1)) GRID_BAR(); } while (0)
    unsigned char* ws = args.ws;
    bf16* hb = (bf16*)(ws + WS_H);
    const float* cosd = (const float*)(ws + WS_ROPE); const float* sind = cosd + (size_t)M * 32; const float* cosm = sind + (size_t)M * 32; const float* sinm = cosm + (size_t)M * 16;

    if (CLS_EN(0) && IN(PH_PRO)) { p_prologue(F, args); } SEAM(PH_PRO);

    for (int L = 0; L < DEPTH; ++L) {
        const int pb = 1 + PH_L * L;
        const float* xin = (L == 0) ? args.in[I_X] : args.out;
        if (CLS_EN(1) && IN(pb + 0)) { norm_rows(F, xin, args.in[I_MIXN] + L * D, hb); } SEAM(pb + 0);
        if (CLS_EN(2) && IN(pb + 1)) {
            pg8::Gemm g{hb, (const bf16*)(ws + WS_WIN) + (size_t)L * NINP * D, D, D}; pg8::StaticOrder S; S.init(M / 256, NINP / 256, F.G, (int)blockIdx.x);
            pg8::EpiCols E{(bf16*)(ws + WS_CR), (bf16*)(ws + WS_CD), (bf16*)(ws + WS_CM), (bf16*)(ws + WS_CH), cosd, sind, cosm, sinm};
            pg8::gemm_phase<pg8::EpiCols, pg8::StaticOrder>(F.lds, g, S, E);
        } SEAM(pb + 1);
        if (CLS_EN(3) && IN(pb + 2)) { p_prepA(F, args, L); } SEAM(pb + 2);
        if (CLS_EN(4) && IN(pb + 3)) {
            { pg8::Gemm g{(const bf16*)(ws + WS_AL), (const bf16*)(ws + WS_WLORA) + (size_t)L * 768 * 256, 256, 256}; pg8::StaticOrder S; S.init(M / 256, 3, F.G, (int)blockIdx.x);
              pg8::EpiLora E{(bf16*)(ws + WS_LO), args.in[I_W0] + L * 256, args.in[I_A0] + L * 256};
              pg8::gemm_phase<pg8::EpiLora, pg8::StaticOrder>(F.lds, g, S, E); }
        }
        if (CLS_EN(18) && IN(pb + 3)) {
            { pg8::Gemm g{(const bf16*)(ws + WS_CM), (const bf16*)(ws + WS_WMLA) + (size_t)L * 1024 * 384, 384, 512}; pg8::StaticOrder S; S.init(M / 256, 4, F.G, (int)blockIdx.x);
              pg8::EpiMla E{(bf16*)(ws + WS_QM), (bf16*)(ws + WS_KVM), (const float*)(ws + MS_RS), cosm, sinm};
              pg8::gemm_phase<pg8::EpiMla, pg8::StaticOrder>(F.lds, g, S, E); }
        } SEAM(pb + 3);
        if (CLS_EN(5) && IN(pb + 4)) { p_attn(F); } SEAM(pb + 4);
        if (CLS_EN(6) && IN(pb + 5)) { p_prepB(F, args, L); } SEAM(pb + 5);
        if (CLS_EN(7) && IN(pb + 6)) { p_scan(F, args, L); } SEAM(pb + 6);
        if (CLS_EN(8) && IN(pb + 7)) { p_post(F, args, L); } SEAM(pb + 7);
        if (CLS_EN(9) && IN(pb + 8)) {
            pg8::Gemm g{hb, (const bf16*)(ws + WS_WOUT) + (size_t)L * D * D, D, D}; pg8::StaticOrder S; S.init(M / 256, 4, F.G, (int)blockIdx.x);
            pg8::EpiResid E{xin, args.out};
            pg8::gemm_phase<pg8::EpiResid, pg8::StaticOrder>(F.lds, g, S, E);
        } SEAM(pb + 8);
        if (L == 0) {
            if (CLS_EN(10) && IN(pb + 9)) { norm_rows(F, args.out, args.in[I_FFNN], hb); } SEAM(pb + 9);
            if (CLS_EN(11) && IN(pb + 10)) {
                pg8::Gemm g{hb, (const bf16*)(ws + WS_W13D), D, D}; pg8::StaticOrder S; S.init(M / 256, 2 * FF / 256, F.G, (int)blockIdx.x);
                pg8::EpiSwiglu E{(bf16*)(ws + WS_ACT), FF};
                pg8::gemm_phase<pg8::EpiSwiglu, pg8::StaticOrder>(F.lds, g, S, E);
            } SEAM(pb + 10);
            if (CLS_EN(12) && IN(pb + 11)) {
                pg8::Gemm g{(const bf16*)(ws + WS_ACT), (const bf16*)(ws + WS_W2D), FF, FF}; pg8::StaticOrder S; S.init(M / 256, 4, F.G, (int)blockIdx.x);
                pg8::EpiResid E{args.out, args.out};
                pg8::gemm_phase<pg8::EpiResid, pg8::StaticOrder>(F.lds, g, S, E);
            } SEAM(pb + 11);
        } else {
            if (CLS_EN(13) && IN(pb + 9)) { norm_router(F, args.out, args.in[I_FFNN] + D, args.in[I_RT], hb); p_moe_weights(F, args); } SEAM(pb + 9);
        }
    }
    if (CLS_EN(14) && IN(PH_SCAT)) { moe_scatter(F); } SEAM(PH_SCAT);
    for (int s = 0; s < 2; ++s) {
        LAS int* tst = (LAS int*)(F.lds + MISC_OFF + 64); LAS int* texp = (LAS int*)(F.lds + MISC_OFF + 128);
        const int* rtok = (const int*)(ws + MS_RTOK) + s * MAXROWS; const float* rgate = (const float*)(ws + MS_RGATE) + s * MAXROWS;
        if (CLS_EN(15) && IN(PH_UP0 + 2 * s)) {
            const int ntl = moe_tables(F, s, tst, texp);
            pg8::MoeOrder S; S.init(ntl, 2 * FFE / 256, F.G, (int)blockIdx.x); S.texp = texp;
            LAS int* gtab = (LAS int*)(F.lds + TAB_OFF);
            { pg8::Unit u; for (int i = 0; i < 16 && S.next(i, u); ++i) { if (F.tid < 256) gtab[i * 256 + F.tid] = rtok[u.pm * 256 + F.tid]; } }
            __syncthreads();
            pg8::Gemm g{hb, (const bf16*)(ws + WS_WM13), D, D};
            pg8::EpiSwiglu E{(bf16*)(ws + WS_ACT), FFE};
            pg8::gemm_phase<pg8::EpiSwiglu, pg8::MoeOrder, true>(F.lds, g, S, E, gtab);
        } SEAM(PH_UP0 + 2 * s);
        if (CLS_EN(16) && IN(PH_DN0 + 2 * s)) {
            const int ntl = moe_tables(F, s, tst, texp);
            pg8::MoeOrder S; S.init(ntl, 4, F.G, (int)blockIdx.x); S.texp = texp;
            pg8::Gemm g{(const bf16*)(ws + WS_ACT), (const bf16*)(ws + WS_WM2), FFE, FFE};
            pg8::EpiMoeDown E{args.out, rtok, rgate};
            pg8::gemm_phase<pg8::EpiMoeDown, pg8::MoeOrder>(F.lds, g, S, E);
        } SEAM(PH_DN0 + 2 * s);
    }
    if (CLS_EN(17) && IN(PH_FIN)) { final_norm_rows(F, args.out, args.in[I_FN]); }
#undef IN
#undef SEAM
}

typedef void (*KernFn)(Args);
template <int C> static void launch_cls(int grid, hipStream_t stream, const Args& a) { hipLaunchKernelGGL(mega_fwd<C>, dim3(grid), dim3(NWAVES * 64), LDS_BYTES, stream, a); }
template <int C> static bool prep_cls() { return hipFuncSetAttribute((const void*)mega_fwd<C>, hipFuncAttributeMaxDynamicSharedMemorySize, LDS_BYTES) == hipSuccess; }
static void launch_class(int c, int grid, hipStream_t stream, const Args& a) {
    switch (c) {
        case 0: launch_cls<0>(grid, stream, a); break; case 1: launch_cls<1>(grid, stream, a); break; case 2: launch_cls<2>(grid, stream, a); break;
        case 3: launch_cls<3>(grid, stream, a); break; case 4: launch_cls<4>(grid, stream, a); break; case 5: launch_cls<5>(grid, stream, a); break;
        case 6: launch_cls<6>(grid, stream, a); break; case 7: launch_cls<7>(grid, stream, a); break; case 8: launch_cls<8>(grid, stream, a); break;
        case 9: launch_cls<9>(grid, stream, a); break; case 10: launch_cls<10>(grid, stream, a); break; case 11: launch_cls<11>(grid, stream, a); break;
        case 12: launch_cls<12>(grid, stream, a); break; case 13: launch_cls<13>(grid, stream, a); break; case 14: launch_cls<14>(grid, stream, a); break;
        case 15: launch_cls<15>(grid, stream, a); break; case 16: launch_cls<16>(grid, stream, a); break; case 17: launch_cls<17>(grid, stream, a); break;
        case 18: launch_cls<18>(grid, stream, a); break; default: break; }
}
extern "C" void kernel_launch(void* const* d_in, const int* in_sizes, int n_in, void* d_out, int out_size, void* d_ws, size_t ws_size, hipStream_t stream) {
    static int grid = 0;
    if (grid == 0) {
        if (n_in != 31 || in_sizes[0] != M * D || out_size != M * D || ws_size < WS_END) { fprintf(stderr, "kernel_launch: unexpected shapes / workspace (%d inputs, ws %zu, need %zu)\n", n_in, ws_size, (size_t)WS_END); grid = -1; return; }
        int dev = 0, cus = 0;
        if (hipGetDevice(&dev) != hipSuccess || hipDeviceGetAttribute(&cus, hipDeviceAttributeMultiprocessorCount, dev) != hipSuccess) { grid = -1; return; }
#if MK_ONE_LAUNCH
        bool ok = prep_cls<-1>();
#else
        bool ok = prep_cls<0>() && prep_cls<1>() && prep_cls<2>() && prep_cls<3>() && prep_cls<4>() && prep_cls<5>() && prep_cls<6>() && prep_cls<7>() && prep_cls<8>() && prep_cls<9>() &&
                  prep_cls<10>() && prep_cls<11>() && prep_cls<12>() && prep_cls<13>() && prep_cls<14>() && prep_cls<15>() && prep_cls<16>() && prep_cls<17>() && prep_cls<18>();
#endif
        if (!ok) { fprintf(stderr, "kernel_launch: hipFuncSetAttribute failed\n"); grid = -1; return; }
        (void)hipGetLastError();
        grid = cus;
        if (grid != 256) { fprintf(stderr, "kernel_launch: built for 256 CUs, found %d\n", cus); grid = -1; return; }
    }
    if (grid < 0) return;
    (void)hipMemsetAsync((char*)d_ws + WS_CTL, 0, CTL_ZERO_BYTES, stream);
    Args a{};
    for (int i = 0; i < 31; ++i) a.in[i] = (const float*)d_in[i];
    a.out = (float*)d_out; a.ws = (unsigned char*)d_ws;
#if MK_ONE_LAUNCH
    a.ph_lo = 0; a.ph_hi = N_PHASES;
    launch_cls<-1>(grid, stream, a);
#else
    for (int p = 0; p < N_PHASES; ++p) { a.ph_lo = p; a.ph_hi = p + 1;
        int c;
        if (p == 0) c = 0; else if (p < 1 + 2 * PH_L - 2) { const int L = (p - 1) / PH_L, j = (p - 1) % PH_L; c = (L == 1 && j == 9) ? 13 : 1 + j; }
        else if (p == PH_SCAT) c = 14; else if (p == PH_UP0 || p == PH_UP1) c = 15; else if (p == PH_DN0 || p == PH_DN1) c = 16; else c = 17;
        launch_class(c, grid, stream, a);
        if (c == 4) launch_class(18, grid, stream, a);
    }
#endif
}
```

```cpp
#include <hip/hip_runtime.h>
#include <cstdio>
#include <cstdint>

#ifndef SITE_MASK
#define SITE_MASK 0xffffffffu
#endif
#define SITE(n) ((SITE_MASK >> (n)) & 1u)
#ifndef REP_MASK
#define REP_MASK 0u
#endif
#ifndef REP_N
#define REP_N 3
#endif
#ifndef SS_MODE
#define SS_MODE 0
#endif
#define REPS(n) (((REP_MASK >> (n)) & 1u) ? REP_N : 1)
#define RUN(n, call) do { for (int r_ = 0; r_ < REPS(n); ++r_) { if (r_) GRID_BAR(); call; } } while (0)
#ifndef MK_ONE_LAUNCH
#define MK_ONE_LAUNCH 1
#endif

#define GAS __attribute__((address_space(1)))
#define LAS __attribute__((address_space(3)))
typedef unsigned short bf16;
typedef unsigned v4u __attribute__((ext_vector_type(4)));
typedef unsigned v2u __attribute__((ext_vector_type(2)));
typedef float f32x2 __attribute__((ext_vector_type(2)));
typedef float f32x4 __attribute__((ext_vector_type(4)));
typedef float f32x16 __attribute__((ext_vector_type(16)));
typedef short bf16x8 __attribute__((ext_vector_type(8)));
typedef short s16x4 __attribute__((ext_vector_type(4)));

constexpr int D = 1024, NB = 16, T = 2048, M = NB * T, DEPTH = 2;
constexpr int NIN = 3232, NINP = 3328;
constexpr int FF = 2816, FFE = 3584, NEXP = 8;
constexpr int MAXT = 135;
constexpr int MAXROWS = MAXT * 256;

constexpr size_t MiB = 1u << 20;
constexpr size_t WS_CTL = 0, CTL_ZERO_BYTES = 256 * 1024;
constexpr size_t WS_WIN = 1 * MiB;
constexpr size_t WS_WOUT = 14 * MiB;
constexpr size_t WS_WLORA = 18 * MiB;
constexpr size_t WS_WMLA = 19 * MiB;
constexpr size_t WS_W13D = 21 * MiB;
constexpr size_t WS_W2D = 32 * MiB;
constexpr size_t WS_ROPE = 38 * MiB;
constexpr size_t WS_MISC = 50 * MiB;
constexpr size_t WS_H = 52 * MiB;
constexpr size_t WS_CR = 116 * MiB;
constexpr size_t WS_CD = 180 * MiB;
constexpr size_t WS_CM = 228 * MiB;
constexpr size_t WS_CH = 260 * MiB;
constexpr size_t WS_AL = 324 * MiB;
constexpr size_t WS_LO = 340 * MiB;
constexpr size_t WS_QM = 388 * MiB;
constexpr size_t WS_KVM = 412 * MiB;
constexpr size_t SP_RP = 180 * MiB;
constexpr size_t SP_KQT = 212 * MiB;
constexpr size_t SP_E = 244 * MiB;
constexpr size_t SP_PC = 252 * MiB;
constexpr size_t SP_BS = 256 * MiB;
constexpr size_t SP_VT = 388 * MiB;
constexpr size_t SP_K2 = 420 * MiB;
constexpr size_t SP_TB = 436 * MiB;
constexpr size_t SP_FM = 440 * MiB;
constexpr size_t SP_AQT = 324 * MiB;
constexpr size_t WS_ACT = 116 * MiB;
constexpr size_t WS_WM13 = 356 * MiB;
constexpr size_t WS_WM2 = 468 * MiB;
constexpr size_t WS_END = 524 * MiB;
static_assert(WS_ACT + (size_t)MAXROWS * FFE * 2 <= WS_WM13, "act vs wm13");
constexpr size_t MS_RS = WS_MISC;
constexpr size_t MS_TOPE = WS_MISC + 256 * 1024;
constexpr size_t MS_GATE = WS_MISC + 512 * 1024;
constexpr size_t MS_RANK = WS_MISC + 768 * 1024;
constexpr size_t MS_RTOK = WS_MISC + 1024 * 1024;
constexpr size_t MS_RGATE = WS_MISC + 1024 * 1024 + 320 * 1024;
static_assert((size_t)2 * MAXROWS * 4 <= 320 * 1024 && MS_RGATE + 320 * 1024 <= WS_H, "misc map");
constexpr int CW_CNT = 64;
constexpr int CW_BAR = 4096;

constexpr int RING_BYTES = 131072;
constexpr int TAB_OFF = RING_BYTES, TAB_BYTES = 16 * 1024;
constexpr int MISC_OFF = TAB_OFF + TAB_BYTES;
constexpr int ARGS_OFF = MISC_OFF + 1024;
constexpr int LDS_BYTES = ARGS_OFF + 512;
constexpr int NWAVES = 8;

#define LDS_WAIT() asm volatile("s_waitcnt lgkmcnt(0)" ::: "memory")
#define VM_WAIT() asm volatile("s_waitcnt vmcnt(0)" ::: "memory")
typedef __bf16 bf16x2_t __attribute__((ext_vector_type(2)));
__device__ __forceinline__ unsigned cvt_pk_bf16(float lo, float hi) { const f32x2 v = {lo, hi}; const bf16x2_t b = __builtin_convertvector(v, bf16x2_t); return __builtin_bit_cast(unsigned, b); }
__device__ __forceinline__ unsigned f2bf(float f) { return cvt_pk_bf16(f, 0.f) & 0xffffu; }
__device__ __forceinline__ unsigned pk2(float lo, float hi) { return cvt_pk_bf16(lo, hi); }
__device__ __forceinline__ float bf2f(unsigned b) { return __builtin_bit_cast(float, b << 16); }
__device__ __forceinline__ float bflo(unsigned w) { return __builtin_bit_cast(float, w << 16); }
__device__ __forceinline__ float bfhi(unsigned w) { return __builtin_bit_cast(float, w & 0xffff0000u); }
__device__ __forceinline__ unsigned cvt_pk_bf16_asm(float lo, float hi) { unsigned r; asm volatile("v_cvt_pk_bf16_f32 %0, %1, %2" : "=v"(r) : "v"(lo), "v"(hi)); return r; }
__device__ __forceinline__ float fexp(float x) { return __builtin_amdgcn_exp2f(x * 1.4426950408889634f); }
__device__ __forceinline__ float frcp(float x) { return __builtin_amdgcn_rcpf(x); }
__device__ __forceinline__ float sigmoidf_(float x) { return frcp(1.0f + fexp(-x)); }
__device__ __forceinline__ float siluf_(float x) { return x * sigmoidf_(x); }
__device__ __forceinline__ float tanhf_(float x) { return 1.0f - 2.0f * frcp(1.0f + fexp(2.0f * x)); }
__device__ __forceinline__ float wave_sum(float v) {
#pragma unroll
    for (int o = 1; o < 64; o <<= 1) v += __shfl_xor(v, o);
    return v;
}
template <int CTRL> __device__ __forceinline__ float dpp_f(float v) { return __builtin_bit_cast(float, __builtin_amdgcn_update_dpp(0, __builtin_bit_cast(int, v), CTRL, 0xf, 0xf, false)); }
template <int CTRL, int RMASK> __device__ __forceinline__ float dpp_rm(float v) { return __builtin_bit_cast(float, __builtin_amdgcn_update_dpp(0, __builtin_bit_cast(int, v), CTRL, RMASK, 0xf, false)); }
__device__ __forceinline__ float row16_sum(float v);
__device__ __forceinline__ float wave_sum_dpp(float v) {
    v = row16_sum(v);
    v += dpp_rm<0x142, 0xa>(v);
    v += dpp_rm<0x143, 0xc>(v);
    return __builtin_bit_cast(float, __builtin_amdgcn_readlane(__builtin_bit_cast(int, v), 63));
}
__device__ __forceinline__ float row16_sum(float v) {
    v += dpp_f<0x128>(v);
    v += dpp_f<0x124>(v);
    v += dpp_f<0x122>(v);
    v += dpp_f<0x121>(v);
    return v;
}

#define BAR_WS_ARG (ARGS_OFF + 8 * 32)
#define WS_CTL_BAR_BYTES (WS_CTL + (size_t)CW_BAR * 4)
#define BAR_ST_OFF (MISC_OFF + 32)
__device__ __forceinline__ unsigned long long lds_arg_u64(int byte_off) { const v2u w = *(const LAS v2u*)(unsigned)byte_off;
    const unsigned lo = __builtin_amdgcn_readfirstlane(w.x), hi = __builtin_amdgcn_readfirstlane(w.y); return ((unsigned long long)hi << 32) | lo; }
#define XB_TMO      128
#define XB_XCNT(j)  (256  + 64 * (j))
#define XB_XSUB(j)  (1280 + 64 * (j))
#define XB_XGEN(j)  (2304 + 64 * (j))
#define XB_TOP      3328
#define XB_TOPGEN   3392
#define XCD_BAR_WORDS 3456
#define XB_SPIN_CAP (1u << 18)
__device__ __forceinline__ unsigned xb_ld(unsigned* p)              { return __hip_atomic_load(p, __ATOMIC_RELAXED, __HIP_MEMORY_SCOPE_AGENT); }
__device__ __forceinline__ unsigned xb_add(unsigned* p, unsigned v) { return __hip_atomic_fetch_add(p, v, __ATOMIC_RELAXED, __HIP_MEMORY_SCOPE_AGENT); }
__device__ __forceinline__ unsigned xb_xcc_id() { return (unsigned)__builtin_amdgcn_s_getreg((3 << 11) | 20) & 0xFu; }
#define XB_SPIN(cond, bar) do { unsigned _sp = 0; while (cond) { __builtin_amdgcn_s_sleep(1); \
    if ((++_sp & 255u) == 0u) { if (xb_ld(&(bar)[XB_TMO])) break; if (_sp > XB_SPIN_CAP) { atomicAdd(&(bar)[XB_TMO], 1u); break; } } } } while (0)
struct XcdBarrier { unsigned* bar; unsigned x; volatile LAS unsigned* st; };
__device__ __forceinline__ XcdBarrier xcd_barrier_post(unsigned* bar, volatile LAS unsigned* st) {
    XcdBarrier b; b.bar = bar; b.x = xb_xcc_id(); b.st = st;
    if (threadIdx.x == 0) (void)xb_add(&bar[XB_XCNT(b.x)], 1u);
    return b;
}
__device__ __forceinline__ void xcd_barrier_complete(unsigned* bar, unsigned x, unsigned& nloc, unsigned& nx) {
    const unsigned G = gridDim.x * gridDim.y * gridDim.z;
    unsigned sum, cnt, mine, sp = 0u;
    for (;;) {
        sum = 0u; cnt = 0u; mine = 0u;
#pragma unroll
        for (unsigned j = 0; j < 16; ++j) { const unsigned c = xb_ld(&bar[XB_XCNT(j)]); sum += c; cnt += (c > 0u) ? 1u : 0u; mine = (j == x) ? c : mine; }
        if (sum == G) break;
        __builtin_amdgcn_s_sleep(1);
        if ((++sp & 255u) == 0u) { if (xb_ld(&bar[XB_TMO])) break; if (sp > XB_SPIN_CAP) { atomicAdd(&bar[XB_TMO], 1u); break; } }
    }
    nloc = mine > 0u ? mine : 1u; nx = cnt > 0u ? cnt : 1u;
}
__device__ __attribute__((noinline)) void xcd_barrier() {
    XcdBarrier b; b.bar = (unsigned*)(GAS unsigned*)(lds_arg_u64(BAR_WS_ARG) + WS_CTL_BAR_BYTES); b.x = xb_xcc_id(); b.st = (volatile LAS unsigned*)(unsigned)(BAR_ST_OFF);
    asm volatile("s_waitcnt vmcnt(0)" ::: "memory");
    __syncthreads();
    if (threadIdx.x == 0) {
        unsigned* bar = b.bar;
        __builtin_amdgcn_s_waitcnt(0);
        unsigned nloc = b.st[0], nx = b.st[1];
        if (nloc == 0u) { xcd_barrier_complete(bar, b.x, nloc, nx); b.st[0] = nloc; b.st[1] = nx; }
        const unsigned old = xb_add(&bar[XB_XSUB(b.x)], 1u);
        const unsigned gen = old / nloc;
        if (old + 1u == (gen + 1u) * nloc) {
            __builtin_amdgcn_fence(__ATOMIC_RELEASE, "agent");
            asm volatile("s_waitcnt vmcnt(0)" ::: "memory");
            const unsigned og = xb_add(&bar[XB_TOP], 1u);
            const unsigned tg = og / nx;
            if (og + 1u == (tg + 1u) * nx) xb_add(&bar[XB_TOPGEN], 1u);
            else XB_SPIN(xb_ld(&bar[XB_TOPGEN]) == tg, bar);
            __builtin_amdgcn_fence(__ATOMIC_ACQUIRE, "agent");
            xb_add(&bar[XB_XGEN(b.x)], 1u);
            asm volatile("s_waitcnt vmcnt(0)" ::: "memory");
        } else {
            XB_SPIN(xb_ld(&bar[XB_XGEN(b.x)]) == gen, bar);
            __builtin_amdgcn_fence(__ATOMIC_ACQUIRE, "agent");
            asm volatile("s_waitcnt vmcnt(0)" ::: "memory");
        }
    }
    __syncthreads();
}

namespace pg8 {
constexpr int BM = 256, BK = 64, HALF = 128, HTB = HALF * BK * 2, STAGE_BYTES = 8 * HTB, NXCD = 8, WGM = 4;
__host__ __device__ __forceinline__ int lds_byte(int r, int c) { const int st = (r >> 4) * 2 + (c >> 5), rr = r & 15, cc = c & 31, ob = rr * 64 + cc * 2; return st * 1024 + (ob ^ (((ob >> 9) & 1) << 5)); }
__host__ __device__ __forceinline__ void stage_rc(int b, int& R, int& C) { const int st = b / 1024, sb = b % 1024, swz = sb ^ (((sb >> 9) & 1) << 5); R = (st >> 1) * 16 + swz / 64; C = (st & 1) * 32 + (swz % 64) / 2; }
__host__ __device__ __forceinline__ int perm32(int rho) { const int n = rho >> 4, i = rho & 15; return 8 * (i >> 2) + 4 * n + (i & 3); }

struct Unit { int pm, pn, ks, su; };
struct Gemm { const bf16* A; const bf16* Bt; int K; int lda; int ldb; };

struct StaticOrder {
    int nM, nN, nwg, G, c, lim;
    __device__ void init(int nM_, int nN_, int G_, int c_) { nM = nM_; nN = nN_; nwg = nM * nN; G = G_; c = c_; lim = nwg; }
    __device__ void decode(int L, Unit& u) const {
        int wgid = L; { const int q = nwg / NXCD, r = nwg % NXCD, xcd = wgid % NXCD, off = wgid / NXCD; wgid = (xcd < r ? xcd * (q + 1) : r * (q + 1) + (xcd - r) * q) + off; }
        const int nig = WGM * nN, gid = wgid / nig, fm = gid * WGM, gsz = (nM - fm) < WGM ? (nM - fm) : WGM;
        u.pm = fm + ((wgid % nig) % gsz); u.pn = (wgid % nig) / gsz; u.ks = 0; u.su = L;
    }
    __device__ bool next(int i, Unit& u) const { const long L = (long)i * G + c; if (L >= lim) return false; decode((int)L, u); return true; }
    __device__ __forceinline__ int a_tile(const Unit& u) const { return u.pm; }
    __device__ __forceinline__ int b_tile(const Unit& u) const { return u.pn; }
    __device__ __forceinline__ const char* b_ptr(const Unit& u, const void* Bt, size_t tstepB) const { return (const char*)Bt + (size_t)u.pn * tstepB; }
    __device__ __forceinline__ int k_off(const Unit&) const { return 0; }
};
struct MoeOrder : StaticOrder {
    const LAS int* texp;
    __device__ __forceinline__ int b_tile(const Unit& u) const { return texp[u.pm] * nN + u.pn; }
    __device__ __forceinline__ const char* b_ptr(const Unit& u, const void* Bt, size_t tstepB) const { return (const char*)Bt + (size_t)(texp[u.pm] * nN + u.pn) * tstepB; }
};
struct MoeUpOrder : MoeOrder {
    const LAS unsigned char* ebase;
    __device__ __forceinline__ const char* b_ptr(const Unit& u, const void*, size_t tstepB) const {
        const v2u w = *(const LAS v2u*)(ebase + 8 * texp[u.pm]); const unsigned lo = __builtin_amdgcn_readfirstlane(w.x), hi = __builtin_amdgcn_readfirstlane(w.y);
        return (const char*)(const GAS char*)(((unsigned long long)hi << 32) | lo) + (size_t)u.pn * tstepB; }
};
struct MoeTailOrder : MoeOrder {
    int first, nsub, KS, Ksub;
    __device__ bool next(int i, Unit& u) const { const long j = (long)i * G + c; if (j >= nsub) return false; decode(first + (int)(j / KS), u); u.ks = (int)(j % KS); return true; }
    __device__ __forceinline__ int k_off(const Unit& u) const { return u.ks * Ksub; }
};

template <class Epi, class Sched, bool GATHER = false>
__device__ __forceinline__ void gemm_phase(LAS unsigned char* lds, const Gemm g, const Sched& S, const Epi& E, const LAS int* gtab = nullptr) {
    int tid_ = threadIdx.x; asm volatile("" : "+v"(tid_));
    const int tid = tid_, wid = __builtin_amdgcn_readfirstlane(tid >> 6), lane = tid & 63, wr = wid >> 2, wc = wid & 3, fr = lane & 15, fq = lane >> 4;
    const int K = g.K, nt = K / BK, lda = g.lda, ldb = g.ldb;
    unsigned voffB[2]; unsigned vA0[2], vA1[2];
#pragma unroll
    for (int i = 0; i < 2; ++i) { int R, C; stage_rc(tid * 16 + i * 8192, R, C); const int Rb = Epi::PERM ? ((R & ~31) + perm32(R & 31)) : R;
        voffB[i] = (unsigned)(Rb * ldb + C) * 2u;
        vA0[i] = (unsigned)(R * lda + C) * 2u; vA1[i] = (unsigned)((R + HALF) * lda + C) * 2u; }
    const size_t kstep = (size_t)(BK * 2);
    const size_t hstep = (size_t)HALF * ldb * 2;
    const size_t tstepB = 2 * hstep;
    const size_t tstepA = (size_t)BM * lda * 2;
    const unsigned ldsw = (unsigned)wid * 1024u;
    const int aoff = lds_byte(wr * 64 + fr, fq * 8), boff = lds_byte(wc * 32 + fr, fq * 8);
#define PG8_SA(b, h) (((b) * 2 + (h)) * HTB)
#define PG8_SB(b, h) ((4 + (b) * 2 + (h)) * HTB)
#define PG8_STAGE(bufoff, gbase, voff) do { _Pragma("unroll") for (int _i = 0; _i < 2; ++_i) \
        __builtin_amdgcn_global_load_lds((const unsigned*)((const char*)(gbase) + (voff)[_i]), (LAS unsigned*)(lds + (bufoff) + ldsw + _i * 8192), 16, 0, 0); } while (0)
#define PG8_LDA(dst, b, h) do { _Pragma("unroll") for (int m = 0; m < 4; ++m) _Pragma("unroll") for (int k = 0; k < 2; ++k) dst[m][k] = *(const LAS bf16x8*)(lds + PG8_SA(b, h) + aoff + m * 2048 + k * 1024); } while (0)
#define PG8_LDB(dst, b, h) do { _Pragma("unroll") for (int n = 0; n < 2; ++n) _Pragma("unroll") for (int k = 0; k < 2; ++k) dst[n][k] = *(const LAS bf16x8*)(lds + PG8_SB(b, h) + boff + n * 2048 + k * 1024); } while (0)
#define PG8_MMA(ai, bj, At, Bt) do { __builtin_amdgcn_s_setprio(1); _Pragma("unroll") for (int m = 0; m < 4; ++m) _Pragma("unroll") for (int n = 0; n < 2; ++n) _Pragma("unroll") for (int k = 0; k < 2; ++k) \
        acc[ai][bj][m][n] = __builtin_amdgcn_mfma_f32_16x16x32_bf16(Bt[n][k], At[m][k], acc[ai][bj][m][n], 0, 0, 0); __builtin_amdgcn_s_setprio(0); } while (0)
#define PG8_WAIT_V(n) asm volatile("s_waitcnt vmcnt(" #n ")" ::: "memory")
#define PG8_WAIT_L(n) asm volatile("s_waitcnt lgkmcnt(" #n ")" ::: "memory")
#define PG8_BAR __builtin_amdgcn_s_barrier()
#define PG8_SCHED __builtin_amdgcn_sched_barrier(0)
    Unit cur, nxt; int ui = 0;
    if (!S.next(0, cur)) return;
    f32x4 acc[2][2][4][2];
    float zf = 0.f; asm volatile("" : "+v"(zf));
#pragma unroll
    for (int a = 0; a < 2; ++a)
#pragma unroll
        for (int b = 0; b < 2; ++b)
#pragma unroll
            for (int m = 0; m < 4; ++m)
#pragma unroll
                for (int n = 0; n < 2; ++n) acc[a][b][m][n] = (f32x4){zf, zf, zf, zf};
    bf16x8 At[4][2], B0[2][2], B1[2][2];
    const char* cA; const char* cB = S.b_ptr(cur, g.Bt, tstepB) + (size_t)S.k_off(cur) * 2;
    if constexpr (GATHER) {
        cA = (const char*)g.A;
        asm volatile("" ::: "memory");
#pragma unroll
        for (int i = 0; i < 2; ++i) { int R, C; stage_rc(tid * 16 + i * 8192, R, C); int t0 = gtab[R], t1 = gtab[HALF + R]; t0 = t0 < 0 ? 0 : t0; t1 = t1 < 0 ? 0 : t1;
            vA0[i] = (unsigned)(t0 * lda + C) * 2u; vA1[i] = (unsigned)(t1 * lda + C) * 2u; }
        asm volatile("s_waitcnt lgkmcnt(0)" ::: "memory");
    } else cA = (const char*)g.A + (size_t)S.a_tile(cur) * tstepA + (size_t)S.k_off(cur) * 2;
    PG8_STAGE(PG8_SB(0, 0), cB, voffB); PG8_STAGE(PG8_SA(0, 0), cA, vA0); PG8_STAGE(PG8_SB(0, 1), cB + hstep, voffB); PG8_STAGE(PG8_SA(0, 1), cA, vA1);
    if (wr == 1) PG8_BAR;
    PG8_WAIT_V(4); PG8_BAR;
    PG8_STAGE(PG8_SB(1, 0), cB + kstep, voffB); PG8_STAGE(PG8_SA(1, 0), cA + kstep, vA0); PG8_STAGE(PG8_SB(1, 1), cB + hstep + kstep, voffB);
    PG8_WAIT_V(6); PG8_BAR;
    for (;;) {
        const bool has_next = S.next(ui + 1, nxt);
        const char* nA; const char* nB = has_next ? S.b_ptr(nxt, g.Bt, tstepB) + (size_t)S.k_off(nxt) * 2 : cB;
        if constexpr (GATHER) nA = cA; else nA = has_next ? (const char*)g.A + (size_t)S.a_tile(nxt) * tstepA + (size_t)S.k_off(nxt) * 2 : cA;
#pragma unroll 1
        for (int t = 0; t < nt; t += 2) {
            const bool last = (t == nt - 2);
            const char* a1 = cA + (size_t)(t + 1) * kstep;
            const char* a2 = last ? nA : cA + (size_t)(t + 2) * kstep; const char* b2 = last ? nB : cB + (size_t)(t + 2) * kstep;
            const char* a3 = a2 + kstep; const char* b3 = b2 + kstep;
            unsigned t1v[2] = {vA1[0], vA1[1]};
            if constexpr (GATHER) {
                if (last && has_next) {
                    asm volatile("" ::: "memory");
                    const LAS int* tb = gtab + (ui + 1) * 256;
#pragma unroll
                    for (int i = 0; i < 2; ++i) { int R, C; stage_rc(tid * 16 + i * 8192, R, C); int t0 = tb[R], t1 = tb[HALF + R]; t0 = t0 < 0 ? 0 : t0; t1 = t1 < 0 ? 0 : t1;
                        vA0[i] = (unsigned)(t0 * lda + C) * 2u; t1v[i] = (unsigned)(t1 * lda + C) * 2u; }
                    asm volatile("s_waitcnt lgkmcnt(0)" ::: "memory");
                }
            }
            PG8_LDB(B0, 0, 0); PG8_SCHED; PG8_LDA(At, 0, 0); PG8_STAGE(PG8_SA(1, 1), a1, vA1);
            if constexpr (GATHER) { vA1[0] = t1v[0]; vA1[1] = t1v[1]; }
            PG8_WAIT_L(8); PG8_BAR; PG8_WAIT_L(0); PG8_MMA(0, 0, At, B0); PG8_BAR; PG8_SCHED;
            PG8_LDB(B1, 0, 1); PG8_STAGE(PG8_SB(0, 0), b2, voffB);
            PG8_BAR; PG8_WAIT_L(0); PG8_MMA(0, 1, At, B1); PG8_BAR;
            PG8_LDA(At, 0, 1); PG8_STAGE(PG8_SA(0, 0), a2, vA0);
            PG8_BAR; PG8_WAIT_L(0); PG8_MMA(1, 0, At, B0); PG8_BAR; PG8_SCHED;
            PG8_STAGE(PG8_SB(0, 1), b2 + hstep, voffB);
            PG8_WAIT_V(6); PG8_BAR; PG8_MMA(1, 1, At, B1); PG8_BAR;
            PG8_LDB(B0, 1, 0); PG8_SCHED; PG8_LDA(At, 1, 0); PG8_STAGE(PG8_SA(0, 1), a2, vA1);
            PG8_WAIT_L(8); PG8_BAR; PG8_WAIT_L(0); PG8_MMA(0, 0, At, B0); PG8_BAR; PG8_SCHED;
            PG8_LDB(B1, 1, 1); PG8_STAGE(PG8_SB(1, 0), b3, voffB);
            PG8_BAR; PG8_WAIT_L(0); PG8_MMA(0, 1, At, B1); PG8_BAR;
            PG8_LDA(At, 1, 1); PG8_STAGE(PG8_SA(1, 0), a3, vA0);
            PG8_BAR; PG8_WAIT_L(0); PG8_MMA(1, 0, At, B0); PG8_BAR; PG8_SCHED;
            PG8_STAGE(PG8_SB(1, 1), b3 + hstep, voffB);
            PG8_WAIT_V(6); PG8_BAR; PG8_MMA(1, 1, At, B1); PG8_BAR;
        }
        E(acc, cur, wr, wc, fr, fq);
        if (!has_next) break;
#pragma unroll
        for (int a = 0; a < 2; ++a)
#pragma unroll
            for (int b = 0; b < 2; ++b)
#pragma unroll
                for (int m = 0; m < 4; ++m)
#pragma unroll
                    for (int n = 0; n < 2; ++n) acc[a][b][m][n] = (f32x4){zf, zf, zf, zf};
        cur = nxt; cA = nA; cB = nB; ++ui;
    }
    PG8_WAIT_V(0);
    if (wr == 0) PG8_BAR;
    PG8_BAR;
#undef PG8_SA
#undef PG8_SB
#undef PG8_STAGE
#undef PG8_LDA
#undef PG8_LDB
#undef PG8_MMA
#undef PG8_WAIT_V
#undef PG8_WAIT_L
#undef PG8_BAR
#undef PG8_SCHED
}

typedef const f32x4 (&AccRef)[2][2][4][2];

#define EPI_FENCE() do { asm volatile("" ::: "memory"); __builtin_amdgcn_sched_barrier(0); } while (0)
__device__ __forceinline__ v4u pack8(const f32x4& v0, const f32x4& v1) { v4u w; w.x = cvt_pk_bf16_asm(v0[0], v0[1]); w.y = cvt_pk_bf16_asm(v0[2], v0[3]); w.z = cvt_pk_bf16_asm(v1[0], v1[1]); w.w = cvt_pk_bf16_asm(v1[2], v1[3]); return w; }
struct EpiCols {
    static constexpr bool PERM = true;
    bf16 *cr, *cd, *cm, *ch; const float *cosd, *sind, *cosm, *sinm;
    __device__ __forceinline__ void operator()(AccRef acc, const Unit& u, int wr, int wc, int fr, int fq) const {
        const int pn = u.pn; bf16* base; int ldc, colt;
        if (pn < 4) { base = cr; ldc = 1024; colt = pn * 256; } else if (pn < 7) { base = cd; ldc = 768; colt = (pn - 4) * 256; }
        else if (pn < 9) { base = cm; ldc = 512; colt = (pn - 7) * 256; } else { base = ch; ldc = 1024; colt = (pn - 9) * 256; }
        const int row0 = u.pm * BM + wr * 64 + fr; const int cl0 = wc * 32 + 8 * fq;
        if (pn == 4 || pn == 5) {
            const int j0 = ((cl0 & 63) >> 3) * 4;
#pragma unroll
            for (int ai = 0; ai < 2; ++ai)
#pragma unroll
                for (int m = 0; m < 4; ++m) { const int row = row0 + ai * HALF + m * 16;
                    const f32x4 c = *(const f32x4*)(cosd + (size_t)row * 32 + j0), s = *(const f32x4*)(sind + (size_t)row * 32 + j0);
#pragma unroll
                    for (int bj = 0; bj < 2; ++bj) { const f32x4 v0 = acc[ai][bj][m][0], v1 = acc[ai][bj][m][1];
                        *(v4u*)(base + (size_t)row * ldc + colt + bj * HALF + cl0) = pack8(v0 * c - v1 * s, v1 * c + v0 * s); }
                    EPI_FENCE(); }
        } else {
            const bool rm = (pn == 8) && (cl0 < 32);
            const int j0 = (cl0 >> 3) * 4;
#pragma unroll
            for (int ai = 0; ai < 2; ++ai)
#pragma unroll
                for (int m = 0; m < 4; ++m) { const int row = row0 + ai * HALF + m * 16;
                    *(v4u*)(base + (size_t)row * ldc + colt + cl0) = pack8(acc[ai][0][m][0], acc[ai][0][m][1]);
                    f32x4 v0 = acc[ai][1][m][0], v1 = acc[ai][1][m][1];
                    if (rm) { const f32x4 c = *(const f32x4*)(cosm + (size_t)row * 16 + j0), s = *(const f32x4*)(sinm + (size_t)row * 16 + j0);
                        const f32x4 a = v0 * c - v1 * s, b = v1 * c + v0 * s; v0 = a; v1 = b; }
                    *(v4u*)(base + (size_t)row * ldc + colt + HALF + cl0) = pack8(v0, v1);
                    EPI_FENCE(); }
        }
    }
};
struct EpiLora {
    static constexpr bool PERM = true;
    bf16* O; const float *w0, *a0;
    __device__ __forceinline__ void operator()(AccRef acc, const Unit& u, int wr, int wc, int fr, int fq) const {
        const int row0 = u.pm * BM + wr * 64 + fr; const int colt = u.pn * BM;
        const float* bias = u.pn == 0 ? w0 : (u.pn == 1 ? a0 : nullptr);
#pragma unroll
        for (int bj = 0; bj < 2; ++bj) { const int cl = bj * HALF + wc * 32 + 8 * fq;
            f32x4 b0 = (f32x4){0.f, 0.f, 0.f, 0.f}, b1 = b0; if (bias) { b0 = *(const f32x4*)(bias + cl); b1 = *(const f32x4*)(bias + cl + 4); }
#pragma unroll
            for (int ai = 0; ai < 2; ++ai)
#pragma unroll
                for (int m = 0; m < 4; ++m) { const int row = row0 + ai * HALF + m * 16;
                    *(v4u*)(O + (size_t)row * 768 + colt + cl) = pack8(acc[ai][bj][m][0] + b0, acc[ai][bj][m][1] + b1); }
            EPI_FENCE(); }
    }
};
struct EpiMla {
    static constexpr bool PERM = true;
    bf16 *QM, *KVM; const float* rs; const float *cosm, *sinm;
    __device__ __forceinline__ void operator()(AccRef acc, const Unit& u, int wr, int wc, int fr, int fq) const {
        const int row0 = u.pm * BM + wr * 64 + fr;
#pragma unroll
        for (int ai = 0; ai < 2; ++ai)
#pragma unroll
            for (int m = 0; m < 4; ++m) { const int row = row0 + ai * HALF + m * 16;
                const f32x2 sc = *(const f32x2*)(rs + (size_t)row * 2);
#pragma unroll
                for (int bj = 0; bj < 2; ++bj) { const int c = u.pn * BM + bj * HALF + wc * 32 + 8 * fq;
                    if (c >= 896) continue;
                    f32x4 v0 = acc[ai][bj][m][0], v1 = acc[ai][bj][m][1];
                    bf16* dst;
                    if (c < 384) { v0 = v0 * sc.x; v1 = v1 * sc.x; const int pos = c % 96;
                        if (pos >= 64) { const int j0 = ((pos - 64) >> 3) * 4;
                            const f32x4 cc = *(const f32x4*)(cosm + (size_t)row * 16 + j0), ss = *(const f32x4*)(sinm + (size_t)row * 16 + j0);
                            const f32x4 a = v0 * cc - v1 * ss, b = v1 * cc + v0 * ss; v0 = a; v1 = b; }
                        dst = QM + (size_t)row * 384 + c; }
                    else { v0 = v0 * sc.y; v1 = v1 * sc.y; dst = KVM + (size_t)row * 512 + (c - 384); }
                    *(v4u*)dst = pack8(v0, v1); }
                EPI_FENCE(); }
    }
};
__device__ __forceinline__ void unpack8(const v4u& w, f32x4& a, f32x4& b) {
    a.x = __builtin_bit_cast(float, w.x << 16); a.y = __builtin_bit_cast(float, w.x & 0xffff0000u); a.z = __builtin_bit_cast(float, w.y << 16); a.w = __builtin_bit_cast(float, w.y & 0xffff0000u);
    b.x = __builtin_bit_cast(float, w.z << 16); b.y = __builtin_bit_cast(float, w.z & 0xffff0000u); b.z = __builtin_bit_cast(float, w.w << 16); b.w = __builtin_bit_cast(float, w.w & 0xffff0000u); }
struct EpiResid {
    static constexpr bool PERM = true;
    const float* res32; const bf16* res; bf16* out;
    __device__ __forceinline__ void operator()(AccRef acc, const Unit& u, int wr, int wc, int fr, int fq) const {
        const int row0 = u.pm * BM + wr * 64 + fr, col0 = u.pn * BM + wc * 32 + 8 * fq;
#pragma unroll
        for (int ai = 0; ai < 2; ++ai)
#pragma unroll
            for (int m = 0; m < 4; ++m) { const size_t ro = (size_t)(row0 + ai * HALF + m * 16) * 1024 + col0;
                f32x4 r[2][2];
                if (res32) {
#pragma unroll
                    for (int bj = 0; bj < 2; ++bj) { r[bj][0] = *(const f32x4*)(res32 + ro + bj * HALF); r[bj][1] = *(const f32x4*)(res32 + ro + bj * HALF + 4); }
                } else {
                    v4u w[2];
#pragma unroll
                    for (int bj = 0; bj < 2; ++bj) w[bj] = *(const v4u*)(res + ro + bj * HALF);
#pragma unroll
                    for (int bj = 0; bj < 2; ++bj) unpack8(w[bj], r[bj][0], r[bj][1]);
                }
#pragma unroll
                for (int bj = 0; bj < 2; ++bj) *(v4u*)(out + ro + bj * HALF) = pack8(r[bj][0] + acc[ai][bj][m][0], r[bj][1] + acc[ai][bj][m][1]);
                EPI_FENCE(); }
    }
};
struct EpiSwiglu {
    static constexpr bool PERM = true;
    bf16* O; int ldc;
    __device__ __forceinline__ void operator()(AccRef acc, const Unit& u, int wr, int wc, int fr, int fq) const {
        const int row0 = u.pm * BM + wr * 64 + fr, col0 = u.pn * HALF + wc * 32 + 8 * fq;
#pragma unroll
        for (int ai = 0; ai < 2; ++ai)
#pragma unroll
            for (int m = 0; m < 4; ++m) { const int row = row0 + ai * HALF + m * 16;
                float r[8];
#pragma unroll
                for (int n = 0; n < 2; ++n)
#pragma unroll
                    for (int j = 0; j < 4; ++j) { const float gte = acc[ai][0][m][n][j], up = acc[ai][1][m][n][j]; r[n * 4 + j] = gte * frcp(1.0f + fexp(-gte)) * up; }
                v4u w; w.x = cvt_pk_bf16_asm(r[0], r[1]); w.y = cvt_pk_bf16_asm(r[2], r[3]); w.z = cvt_pk_bf16_asm(r[4], r[5]); w.w = cvt_pk_bf16_asm(r[6], r[7]);
                *(v4u*)(O + (size_t)row * ldc + col0) = w;
                EPI_FENCE(); }
    }
};
struct EpiMoeDown {
    static constexpr bool PERM = true;
    const bf16* xs; bf16* xd; const int* rtok; const float* rgate;
    __device__ __forceinline__ void operator()(AccRef acc, const Unit& u, int wr, int wc, int fr, int fq) const {
        const int row0 = u.pm * BM + wr * 64 + fr, col0 = u.pn * BM + wc * 32 + 8 * fq;
#pragma unroll
        for (int ai = 0; ai < 2; ++ai)
#pragma unroll
            for (int m = 0; m < 4; ++m) { const int row = row0 + ai * HALF + m * 16; const int tok = rtok[row]; const float gt = rgate[row];
                if (tok >= 0) { const size_t ro = (size_t)tok * 1024 + col0;
                    v4u w[2]; f32x4 r[2][2];
#pragma unroll
                    for (int bj = 0; bj < 2; ++bj) w[bj] = *(const v4u*)(xs + ro + bj * HALF);
#pragma unroll
                    for (int bj = 0; bj < 2; ++bj) unpack8(w[bj], r[bj][0], r[bj][1]);
#pragma unroll
                    for (int bj = 0; bj < 2; ++bj) *(v4u*)(xd + ro + bj * HALF) = pack8(r[bj][0] + acc[ai][bj][m][0] * gt, r[bj][1] + acc[ai][bj][m][1] * gt); }
                EPI_FENCE(); }
    }
};
struct EpiPartial {
    static constexpr bool PERM = false;
    float* part; int first, KS;
    __device__ __forceinline__ void operator()(AccRef acc, const Unit& u, int wr, int wc, int fr, int fq) const {
        float* base = part + (size_t)((u.su - first) * KS + u.ks) * 65536; const int r0 = wr * 64 + fr, c0 = wc * 32 + 4 * fq;
#pragma unroll
        for (int ai = 0; ai < 2; ++ai)
#pragma unroll
            for (int m = 0; m < 4; ++m) { float* rp = base + (size_t)(r0 + ai * HALF + m * 16) * 256 + c0;
#pragma unroll
                for (int q = 0; q < 4; ++q) *(f32x4*)(rp + (q >> 1) * HALF + (q & 1) * 16) = acc[ai][q >> 1][m][q & 1];
                EPI_FENCE(); }
    }
};
}

struct Args { const float* in[31]; float* out; unsigned char* ws; int ph_lo, ph_hi; };
enum { I_X = 0, I_POS, I_MIXN, I_WIN, I_WOUT, I_MU, I_W0, I_W2, I_A0, I_A2, I_G2, I_KK, I_KA, I_RK, I_LNW, I_LNB, I_QN, I_WUQ, I_KVN, I_WUKV, I_LB, I_GN, I_FFNN, I_F1, I_F3, I_F2, I_RT, I_M1, I_M3, I_M2, I_FN };

struct Frame {
    LAS unsigned char* lds; volatile LAS unsigned* MISC; unsigned* ctl;
    int tid, lane, wave, vcu, G;
    unsigned char* ws; float* out;
};
__device__ __forceinline__ unsigned long long ld_u64(const LAS unsigned char* p) { const v2u w = *(const LAS v2u*)p;
    const unsigned lo = __builtin_amdgcn_readfirstlane(w.x), hi = __builtin_amdgcn_readfirstlane(w.y); return ((unsigned long long)hi << 32) | lo; }
#define AIN(i) ((const float*)(const GAS float*)ld_u64(F.lds + ARGS_OFF + 8 * (i)))
__device__ __forceinline__ void frame_init(Frame& F) {
    extern __shared__ __attribute__((aligned(16))) unsigned char lds[];
    F.lds = (LAS unsigned char*)lds; F.MISC = (volatile LAS unsigned*)(F.lds + MISC_OFF);
    { int t_ = threadIdx.x; asm volatile("" : "+v"(t_)); F.tid = t_; } F.lane = F.tid & 63; F.wave = __builtin_amdgcn_readfirstlane(F.tid >> 6);
    F.G = gridDim.x; { const int bx = blockIdx.x; F.vcu = (F.G % 8 == 0) ? (bx % 8) * (F.G / 8) + bx / 8 : bx; }
    F.out = (float*)(GAS float*)ld_u64(F.lds + ARGS_OFF + 8 * 31); F.ws = (unsigned char*)(GAS unsigned char*)ld_u64(F.lds + ARGS_OFF + 8 * 32); F.ctl = (unsigned*)(F.ws + WS_CTL);
}

template <class Map>
__device__ __forceinline__ void tr_load(const Map& mp, f32x4 (&v)[16], int item, int nblk, int lane) {
    const int kb = item / nblk, nb = item % nblk, k0 = 64 * kb, n0 = 64 * nb;
    const int g = lane & 15, r = lane >> 4;
    const float* colp = mp.col(n0 + 4 * g); const size_t ld = mp.ld;
#pragma unroll
    for (int i = 0; i < 16; ++i) v[i] = colp ? *(const f32x4*)(colp + (size_t)(k0 + 4 * i + r) * ld) : (f32x4){0.f, 0.f, 0.f, 0.f};
}
__device__ __forceinline__ void tr_store(const f32x4 (&v)[16], int K, bf16* dst, LAS float* scr, int item, int nblk, int lane) {
    const int kb = item / nblk, nb = item % nblk, k0 = 64 * kb, n0 = 64 * nb;
    const int g = lane & 15, r = lane >> 4;
#pragma unroll
    for (int i = 0; i < 16; ++i) { LAS float* p = scr + (4 * i + r) * 65 + 4 * g; p[0] = v[i].x; p[1] = v[i].y; p[2] = v[i].z; p[3] = v[i].w; }
    LDS_WAIT(); asm volatile("" ::: "memory");
    const int c = lane & 7;
#pragma unroll
    for (int j = 0; j < 8; ++j) { const int n = (lane >> 3) + 8 * j; const LAS float* s = scr + (8 * c) * 65 + n;
        v4u o; o.x = cvt_pk_bf16_asm(s[0 * 65], s[1 * 65]); o.y = cvt_pk_bf16_asm(s[2 * 65], s[3 * 65]); o.z = cvt_pk_bf16_asm(s[4 * 65], s[5 * 65]); o.w = cvt_pk_bf16_asm(s[6 * 65], s[7 * 65]);
        *(v4u*)(dst + (size_t)(n0 + n) * K + k0 + 8 * c) = o; }
    LDS_WAIT(); asm volatile("" ::: "memory");
}
__device__ __forceinline__ int rope_src_dim(int p, int half) { const int g8 = p >> 3, w = p & 7; return (w < 4) ? (4 * g8 + w) : (half + 4 * g8 + (w - 4)); }
struct MapWin { const float* W; size_t ld;
    __device__ __forceinline__ const float* col(int n) const {
        if (n < 1024) return W + n;
        if (n < 1792) { const int q = n - 1024, part = q >> 8, head = (q & 255) >> 6, pos = q & 63; const int dim = (part < 2) ? rope_src_dim(pos, 32) : pos; return W + 1024 + part * 256 + head * 64 + dim; }
        if (n < 2304) { const int q = n - 1792; if (q < 384) return W + 1792 + q; if (q < 416) return W + 2176 + rope_src_dim(q - 384, 16); return nullptr; }
        return W + 2208 + (n - 2304);
    } };
struct MapId { const float* W; size_t ld; __device__ __forceinline__ const float* col(int n) const { return W + n; } };
struct MapW13 { const float *W1, *W3; size_t ld; int noff;
    __device__ __forceinline__ const float* col(int n_) const { const int n = n_ + noff; const int tile = n >> 8, w = n & 255; return (w < 128) ? (W1 + tile * 128 + w) : (W3 + tile * 128 + (w - 128)); } };

template <class Map>
__device__ __forceinline__ void tr_matrix(Frame& F, const Map& mp, int K, int N, bf16* dst) {
    LAS float* scr = (LAS float*)(F.lds + F.wave * 16640);
    const int gw = F.vcu * NWAVES + F.wave, NGW = F.G * NWAVES, nblk = N / 64, nitems = (K / 64) * nblk;
    f32x4 va[16], vb[16];
    if (gw < nitems) tr_load(mp, va, gw, nblk, F.lane);
    for (int it = gw; it < nitems; it += 2 * NGW) {
        const int i1 = it + NGW, i2 = it + 2 * NGW;
        if (i1 < nitems) tr_load(mp, vb, i1, nblk, F.lane);
        tr_store(va, K, dst, scr, it, nblk, F.lane);
        if (i2 < nitems) tr_load(mp, va, i2, nblk, F.lane);
        if (i1 < nitems) tr_store(vb, K, dst, scr, i1, nblk, F.lane);
    }
}

__device__ __forceinline__ float lora_elem(Frame& F, int i) { const int L = i / (768 * 256), r = i % (768 * 256), n = r / 256, k = r % 256; float v = 0.f;
    if (n < 256) { if (k < 64) v = AIN(I_W2)[(size_t)L * 64 * 256 + k * 256 + n]; }
    else if (n < 512) { if (k >= 64 && k < 128) v = AIN(I_A2)[(size_t)L * 64 * 256 + (k - 64) * 256 + (n - 256)]; }
    else { if (k >= 128) v = AIN(I_G2)[(size_t)L * 128 * 256 + (k - 128) * 256 + (n - 512)]; }
    return v; }
__device__ __forceinline__ float mla_elem(Frame& F, int i) { const int L = i / (1024 * 384), r = i % (1024 * 384), n = r / 384, k = r % 384; float v = 0.f;
    if (n < 384) { if (k < 256) { const int head = n / 96, pos = n % 96; const int sc = (pos < 64) ? pos : 64 + rope_src_dim(pos - 64, 16);
            v = AIN(I_QN)[L * 256 + k] * AIN(I_WUQ)[(size_t)L * 256 * 384 + (size_t)k * 384 + head * 96 + sc]; } }
    else if (n < 896) { if (k >= 256) v = AIN(I_KVN)[L * 128 + (k - 256)] * AIN(I_WUKV)[(size_t)L * 128 * 512 + (size_t)(k - 256) * 512 + (n - 384)]; }
    return v; }
__device__ __forceinline__ void p_blockmats(Frame& F) {
    unsigned char* ws = F.ws;
    const int gt = F.vcu * (NWAVES * 64) + F.tid, NGT = F.G * NWAVES * 64;
    for (int i = gt; i < DEPTH * 768 * 256; i += 4 * NGT) { float v[4];
#pragma unroll
        for (int q = 0; q < 4; ++q) v[q] = (i + q * NGT < DEPTH * 768 * 256) ? lora_elem(F, i + q * NGT) : 0.f;
#pragma unroll
        for (int q = 0; q < 4; ++q) if (i + q * NGT < DEPTH * 768 * 256) ((bf16*)(ws + WS_WLORA))[i + q * NGT] = (bf16)f2bf(v[q]); }
    for (int i = gt; i < DEPTH * 1024 * 384; i += 4 * NGT) { float v[4];
#pragma unroll
        for (int q = 0; q < 4; ++q) v[q] = (i + q * NGT < DEPTH * 1024 * 384) ? mla_elem(F, i + q * NGT) : 0.f;
#pragma unroll
        for (int q = 0; q < 4; ++q) if (i + q * NGT < DEPTH * 1024 * 384) ((bf16*)(ws + WS_WMLA))[i + q * NGT] = (bf16)f2bf(v[q]); }
}
__device__ __forceinline__ void p_prologue(Frame& F) {
    unsigned char* ws = F.ws;
    { MapWin mp{AIN(I_WIN), (size_t)NIN}; tr_matrix(F, mp, D, NINP, (bf16*)(ws + WS_WIN)); }
    const int gt = F.vcu * (NWAVES * 64) + F.tid, NGT = F.G * NWAVES * 64;
    float* cosd = (float*)(ws + WS_ROPE); float* sind = cosd + (size_t)M * 32; float* cosm = sind + (size_t)M * 32; float* sinm = cosm + (size_t)M * 16;
    const int* pos = (const int*)AIN(I_POS);
    for (int i = gt; i < M * 48; i += NGT) { const int row = i / 48, j = i % 48; const bool dd = j < 32; const int jj = dd ? j : j - 32;
        const float invf = __builtin_amdgcn_exp2f(-(float)jj * (dd ? (13.287712379549449f / 32.0f) : (13.287712379549449f / 16.0f)));
        const double ang = (double)pos[row] * (double)invf; double rev = ang * 0.15915494309189535; rev -= __builtin_rint(rev);
        const float fr = (float)rev; const float s = __builtin_amdgcn_sinf(fr), c = __builtin_amdgcn_cosf(fr);
        if (dd) { cosd[(size_t)row * 32 + jj] = c; sind[(size_t)row * 32 + jj] = s; } else { cosm[(size_t)row * 16 + jj] = c; sinm[(size_t)row * 16 + jj] = s; } }
}
__device__ __forceinline__ bf16* wm13_base(int e, unsigned char* ws, float* out) {
    return e < 4 ? (bf16*)out + (size_t)e * 2 * FFE * D : (bf16*)(ws + (e == 4 ? 444 * MiB : (e == 5 ? 21 * MiB : (e == 6 ? 1 * MiB : 35 * MiB)))); }
__device__ __forceinline__ void p_moe_weights(Frame& F, Frame& G, int e0, int e1) {
    for (int e = e0; e < e1; ++e) { MapW13 mp{AIN(I_M1) + (size_t)e * D * FFE, AIN(I_M3) + (size_t)e * D * FFE, (size_t)FFE, 0}; tr_matrix(G, mp, D, 2 * FFE, wm13_base(e, F.ws, F.out)); }
}
__device__ __forceinline__ void p_moe_weights2(Frame& F) {
    Frame G2 = F; G2.vcu = F.vcu - 128; G2.G = 128;
    { MapW13 mp{AIN(I_F1), AIN(I_F3), (size_t)FF, 0}; tr_matrix(G2, mp, D, 2 * FF, (bf16*)(F.ws + WS_W13D)); }
    { MapId mp{AIN(I_F2), (size_t)D}; tr_matrix(G2, mp, FF, D, (bf16*)(F.ws + WS_W2D)); }
    { MapWin mp{AIN(I_WIN) + (size_t)D * NIN, (size_t)NIN}; tr_matrix(G2, mp, D, NINP, (bf16*)(F.ws + WS_WIN) + (size_t)NINP * D); }
    { MapId mp{AIN(I_WOUT), (size_t)D}; tr_matrix(G2, mp, D, D, (bf16*)(F.ws + WS_WOUT)); }
    { MapId mp{AIN(I_WOUT) + (size_t)D * D, (size_t)D}; tr_matrix(G2, mp, D, D, (bf16*)(F.ws + WS_WOUT) + (size_t)D * D); }
    for (int e = 0; e < NEXP; ++e) { MapId mp{AIN(I_M2) + (size_t)e * FFE * D, (size_t)D}; tr_matrix(G2, mp, FFE, D, (bf16*)(F.ws + WS_WM2) + (size_t)e * D * FFE); }
}

__device__ __forceinline__ void norm_rows(Frame& F, const float* x, const float* gain, bf16* h) {
    const int gw = F.vcu * NWAVES + F.wave, NGW = F.G * NWAVES;
    f32x4 gv[4];
#pragma unroll
    for (int j = 0; j < 4; ++j) gv[j] = *(const f32x4*)(gain + 4 * F.lane + 256 * j);
    for (int m0 = gw; m0 < M; m0 += 4 * NGW) {
        f32x4 v[4][4]; float s[4];
#pragma unroll
        for (int q = 0; q < 4; ++q) { const f32x4* xr = (const f32x4*)(x + (size_t)(m0 + q * NGW) * D) + F.lane;
#pragma unroll
            for (int j = 0; j < 4; ++j) v[q][j] = xr[64 * j]; }
#pragma unroll
        for (int q = 0; q < 4; ++q) { s[q] = 0.f;
#pragma unroll
            for (int j = 0; j < 4; ++j) s[q] += (v[q][j].x * v[q][j].x + v[q][j].y * v[q][j].y) + (v[q][j].z * v[q][j].z + v[q][j].w * v[q][j].w); }
#pragma unroll
        for (int q = 0; q < 4; ++q) s[q] = wave_sum(s[q]);
#pragma unroll
        for (int q = 0; q < 4; ++q) { const float r = __builtin_amdgcn_rsqf(s[q] * (1.f / D) + 1e-6f);
            v2u* o = (v2u*)(h + (size_t)(m0 + q * NGW) * D) + F.lane;
#pragma unroll
            for (int j = 0; j < 4; ++j) { const f32x4 y = v[q][j] * r * gv[j]; v2u w; w.x = pk2(y.x, y.y); w.y = pk2(y.z, y.w); o[64 * j] = w; } }
    }
}
__device__ __forceinline__ void norm_rows_b(Frame& F, const bf16* x, const float* gain, bf16* h) {
    const int gw = F.vcu * NWAVES + F.wave, NGW = F.G * NWAVES;
    f32x4 gv[2][2];
#pragma unroll
    for (int j = 0; j < 2; ++j) { gv[j][0] = *(const f32x4*)(gain + 8 * F.lane + 512 * j); gv[j][1] = *(const f32x4*)(gain + 8 * F.lane + 512 * j + 4); }
    for (int m0 = gw; m0 < M; m0 += 4 * NGW) {
        v4u w[4][2]; float s[4];
#pragma unroll
        for (int q = 0; q < 4; ++q) { const v4u* xr = (const v4u*)(x + (size_t)(m0 + q * NGW) * D) + F.lane; w[q][0] = xr[0]; w[q][1] = xr[64]; }
#pragma unroll
        for (int q = 0; q < 4; ++q) { s[q] = 0.f;
#pragma unroll
            for (int j = 0; j < 2; ++j) { f32x4 a, b; pg8::unpack8(w[q][j], a, b); s[q] += ((a.x * a.x + a.y * a.y) + (a.z * a.z + a.w * a.w)) + ((b.x * b.x + b.y * b.y) + (b.z * b.z + b.w * b.w)); } }
#pragma unroll
        for (int q = 0; q < 4; ++q) s[q] = wave_sum(s[q]);
#pragma unroll
        for (int q = 0; q < 4; ++q) { const float r = __builtin_amdgcn_rsqf(s[q] * (1.f / D) + 1e-6f);
            v4u* o = (v4u*)(h + (size_t)(m0 + q * NGW) * D) + F.lane;
#pragma unroll
            for (int j = 0; j < 2; ++j) { f32x4 a, b; pg8::unpack8(w[q][j], a, b); const f32x4 y0 = a * r * gv[j][0], y1 = b * r * gv[j][1];
                v4u ow; ow.x = pk2(y0.x, y0.y); ow.y = pk2(y0.z, y0.w); ow.z = pk2(y1.x, y1.y); ow.w = pk2(y1.z, y1.w); o[64 * j] = ow; } }
    }
}
__device__ __forceinline__ void final_norm_rows(Frame& F, const bf16* x, float* out, const float* gain) {
    const int gw = F.vcu * NWAVES + F.wave, NGW = F.G * NWAVES;
    f32x4 gv[2][2];
#pragma unroll
    for (int j = 0; j < 2; ++j) { gv[j][0] = *(const f32x4*)(gain + 8 * F.lane + 512 * j); gv[j][1] = *(const f32x4*)(gain + 8 * F.lane + 512 * j + 4); }
    for (int m0 = gw; m0 < M; m0 += 4 * NGW) {
        v4u w[4][2]; float s[4];
#pragma unroll
        for (int q = 0; q < 4; ++q) { const v4u* xr = (const v4u*)(x + (size_t)(m0 + q * NGW) * D) + F.lane; w[q][0] = xr[0]; w[q][1] = xr[64]; }
#pragma unroll
        for (int q = 0; q < 4; ++q) { s[q] = 0.f;
#pragma unroll
            for (int j = 0; j < 2; ++j) { f32x4 a, b; pg8::unpack8(w[q][j], a, b); s[q] += ((a.x * a.x + a.y * a.y) + (a.z * a.z + a.w * a.w)) + ((b.x * b.x + b.y * b.y) + (b.z * b.z + b.w * b.w)); } }
#pragma unroll
        for (int q = 0; q < 4; ++q) s[q] = wave_sum(s[q]);
#pragma unroll
        for (int q = 0; q < 4; ++q) { const float r = __builtin_amdgcn_rsqf(s[q] * (1.f / D) + 1e-6f);
            float* o = out + (size_t)(m0 + q * NGW) * D + 8 * F.lane;
#pragma unroll
            for (int j = 0; j < 2; ++j) { f32x4 a, b; pg8::unpack8(w[q][j], a, b); *(f32x4*)(o + 512 * j) = a * r * gv[j][0]; *(f32x4*)(o + 512 * j + 4) = b * r * gv[j][1]; } }
    }
}
__device__ __forceinline__ void norm_router(Frame& F, const bf16* x, const float* gain, const float* wr, bf16* h) {
    LAS float* wl = (LAS float*)F.lds;
    LAS int* lcnt = (LAS int*)(F.lds + 32768);
    LAS int* lbase = lcnt + 16;
    LAS int* lrow = lcnt + 32;
    for (int i = F.tid; i < 8192; i += 512) wl[i] = wr[i];
    if (F.tid < 16) lcnt[F.tid] = 0;
    int* rtok = (int*)(F.ws + MS_RTOK); const int gt = F.vcu * 512 + F.tid;
    for (int i = gt; i < 2 * MAXROWS; i += F.G * 512) rtok[i] = -1;
    __syncthreads();
    f32x4 gv[4];
#pragma unroll
    for (int j = 0; j < 4; ++j) gv[j] = *(const f32x4*)(gain + 8 * F.lane + 512 * (j >> 1) + 4 * (j & 1));
    int* tope = (int*)(F.ws + MS_TOPE); float* gate = (float*)(F.ws + MS_GATE); int* rank = (int*)(F.ws + MS_RANK);
    const int rb = blockIdx.x * 128;
    v4u nw0, nw1; { const v4u* xr = (const v4u*)(x + (size_t)(rb + F.wave * 16) * D) + F.lane; nw0 = xr[0]; nw1 = xr[64]; }
    for (int q = 0; q < 16; ++q) { const int lr = F.wave * 16 + q, m = rb + lr;
        f32x4 v[4]; float s = 0.f;
        { const v4u w0 = nw0, w1 = nw1;
          const v4u* xn = (const v4u*)(x + (size_t)(q < 15 ? m + 1 : m) * D) + F.lane; nw0 = xn[0]; nw1 = xn[64];
          pg8::unpack8(w0, v[0], v[1]); pg8::unpack8(w1, v[2], v[3]); }
#pragma unroll
        for (int j = 0; j < 4; ++j) s += (v[j].x * v[j].x + v[j].y * v[j].y) + (v[j].z * v[j].z + v[j].w * v[j].w);
        const float r = __builtin_amdgcn_rsqf(wave_sum(s) * (1.f / D) + 1e-6f);
        float lg[8];
#pragma unroll
        for (int e = 0; e < 8; ++e) lg[e] = 0.f;
        v2u* o = (v2u*)(h + (size_t)m * D + 8 * F.lane);
#pragma unroll
        for (int j = 0; j < 4; ++j) { const f32x4 y = v[j] * r * gv[j]; v2u w; w.x = pk2(y.x, y.y); w.y = pk2(y.z, y.w); o[128 * (j >> 1) + (j & 1)] = w;
#pragma unroll
            for (int c = 0; c < 4; ++c) { const int k = 8 * F.lane + 512 * (j >> 1) + 4 * (j & 1) + c; const f32x4 wa = *(const LAS f32x4*)(wl + k * 8), wb = *(const LAS f32x4*)(wl + k * 8 + 4);
                lg[0] += y[c] * wa.x; lg[1] += y[c] * wa.y; lg[2] += y[c] * wa.z; lg[3] += y[c] * wa.w; lg[4] += y[c] * wb.x; lg[5] += y[c] * wb.y; lg[6] += y[c] * wb.z; lg[7] += y[c] * wb.w; } }
#pragma unroll
        for (int e = 0; e < 8; ++e) lg[e] = wave_sum(lg[e]);
        int e0 = 0; float v0 = lg[0];
#pragma unroll
        for (int e = 1; e < 8; ++e) if (lg[e] > v0) { v0 = lg[e]; e0 = e; }
        int e1 = -1; float v1 = -3.0e38f;
#pragma unroll
        for (int e = 0; e < 8; ++e) if (e != e0 && lg[e] > v1) { v1 = lg[e]; e1 = e; }
        if (F.lane == 0) { const float g1 = frcp(1.0f + fexp(v0 - v1)); const float g0 = 1.0f - g1;
            const int r0 = atomicAdd((int*)&lcnt[e0], 1), r1 = atomicAdd((int*)&lcnt[8 + e1], 1);
            lrow[lr * 4 + 0] = e0; lrow[lr * 4 + 1] = e1; lrow[lr * 4 + 2] = r0; lrow[lr * 4 + 3] = r1;
            tope[m * 2] = e0; tope[m * 2 + 1] = e1; gate[m * 2] = g0; gate[m * 2 + 1] = g1; }
    }
    __syncthreads();
    if (F.tid < 16) lbase[F.tid] = (int)atomicAdd(F.ctl + CW_CNT + F.tid, (unsigned)lcnt[F.tid]);
    __syncthreads();
    if (F.tid < 128) { const int m = rb + F.tid; rank[m * 2] = lbase[lrow[F.tid * 4]] + lrow[F.tid * 4 + 2]; rank[m * 2 + 1] = lbase[8 + lrow[F.tid * 4 + 1]] + lrow[F.tid * 4 + 3]; }
    __syncthreads();
}
__device__ __forceinline__ int moe_tables(Frame& F, int s, LAS int* tstart, LAS int* texp) {
    __syncthreads();
    if (F.tid == 0) { int acc = 0;
        for (int e = 0; e < 8; ++e) { const int c = (int)__hip_atomic_load(F.ctl + CW_CNT + s * 8 + e, __ATOMIC_RELAXED, __HIP_MEMORY_SCOPE_AGENT); const int nt = (c + 255) >> 8; tstart[e] = acc;
#pragma clang loop vectorize(disable) unroll(disable)
            for (int t = 0; t < nt && acc + t < MAXT; ++t) texp[acc + t] = e;
            acc += nt; }
        tstart[8] = acc > MAXT ? MAXT : acc; }
    __syncthreads();
    return tstart[8];
}
__device__ __forceinline__ void moe_scatter(Frame& F) {
    LAS int* tst = (LAS int*)(F.lds + 1024); LAS int* texp = (LAS int*)(F.lds + 2048);
    const int* tope = (const int*)(F.ws + MS_TOPE); const float* gate = (const float*)(F.ws + MS_GATE); const int* rank = (const int*)(F.ws + MS_RANK);
    int* rtok = (int*)(F.ws + MS_RTOK); float* rgate = (float*)(F.ws + MS_RGATE);
    int st0[8], st1[8];
    moe_tables(F, 0, tst, texp);
#pragma unroll
    for (int e = 0; e < 8; ++e) st0[e] = tst[e];
    moe_tables(F, 1, tst, texp);
#pragma unroll
    for (int e = 0; e < 8; ++e) st1[e] = tst[e];
    const int gt = F.vcu * 512 + F.tid;
    for (int m = gt; m < M; m += F.G * 512) {
        const int e0 = tope[m * 2], e1 = tope[m * 2 + 1];
        int b0 = 0, b1 = 0;
#pragma unroll
        for (int e = 0; e < 8; ++e) { b0 = (e == e0) ? st0[e] : b0; b1 = (e == e1) ? st1[e] : b1; }
        const int p0 = b0 * 256 + rank[m * 2], p1 = b1 * 256 + rank[m * 2 + 1];
        if (p0 < MAXROWS) { rtok[p0] = m; rgate[p0] = gate[m * 2]; }
        if (p1 < MAXROWS) { rtok[MAXROWS + p1] = m; rgate[MAXROWS + p1] = gate[m * 2 + 1]; }
    }
}

__device__ __forceinline__ void p_prepA(Frame& F, int L) {
    const bf16* cr = (const bf16*)(F.ws + WS_CR); const bf16* cm = (const bf16*)(F.ws + WS_CM);
    bf16* al = (bf16*)(F.ws + WS_AL); float* rs = (float*)(F.ws + MS_RS);
    const float* mu = AIN(I_MU) + L * 1024 + 768;
    const int gw = F.vcu * NWAVES + F.wave, NGW = F.G * NWAVES;
    f32x4 muv = *(const f32x4*)(mu + 4 * F.lane);
    for (int m0 = gw; m0 < M; m0 += 4 * NGW) {
        v2u cw[4], pw[4], qq[4]; unsigned kv[4]; float sq[4], sk[4];
#pragma unroll
        for (int r = 0; r < 4; ++r) { const int m = m0 + r * NGW; const int t = m & (T - 1);
            cw[r] = *(const v2u*)(cr + (size_t)m * 1024 + 768 + 4 * F.lane);
            pw[r] = (v2u){0u, 0u}; if (t > 0) pw[r] = *(const v2u*)(cr + (size_t)(m - 1) * 1024 + 768 + 4 * F.lane);
            qq[r] = *(const v2u*)(cm + (size_t)m * 512 + 4 * F.lane);
            kv[r] = *(const unsigned*)(cm + (size_t)m * 512 + 256 + 2 * F.lane); }
#pragma unroll
        for (int r = 0; r < 4; ++r) { const int m = m0 + r * NGW;
            float c[4] = {bflo(cw[r].x), bfhi(cw[r].x), bflo(cw[r].y), bfhi(cw[r].y)}, p[4] = {bflo(pw[r].x), bfhi(pw[r].x), bflo(pw[r].y), bfhi(pw[r].y)}, o[4];
#pragma unroll
            for (int j = 0; j < 4; ++j) { const float xs = c[j] + (p[j] - c[j]) * muv[j]; const int col = 4 * F.lane + j; o[j] = (col < 64) ? tanhf_(xs) : ((col < 128) ? xs : sigmoidf_(xs)); }
            v2u w; w.x = pk2(o[0], o[1]); w.y = pk2(o[2], o[3]); *(v2u*)(al + (size_t)m * 256 + 4 * F.lane) = w;
            sq[r] = bflo(qq[r].x) * bflo(qq[r].x) + bfhi(qq[r].x) * bfhi(qq[r].x) + bflo(qq[r].y) * bflo(qq[r].y) + bfhi(qq[r].y) * bfhi(qq[r].y);
            sk[r] = bflo(kv[r]) * bflo(kv[r]) + bfhi(kv[r]) * bfhi(kv[r]); }
#pragma unroll
        for (int r = 0; r < 4; ++r) { sq[r] = wave_sum(sq[r]); sk[r] = wave_sum(sk[r]); }
#pragma unroll
        for (int r = 0; r < 4; ++r) { const int m = m0 + r * NGW;
            if (F.lane == 0) { rs[m * 2] = __builtin_amdgcn_rsqf(sq[r] * (1.f / 256.f) + 1e-6f); rs[m * 2 + 1] = __builtin_amdgcn_rsqf(sk[r] * (1.f / 128.f) + 1e-6f); } }
    }
}
__device__ __forceinline__ void unpk4(const v2u w, float (&o)[4]) { o[0] = bflo(w.x); o[1] = bfhi(w.x); o[2] = bflo(w.y); o[3] = bfhi(w.y); }
__device__ __forceinline__ v2u pk4(const float (&o)[4]) { v2u w; w.x = pk2(o[0], o[1]); w.y = pk2(o[2], o[3]); return w; }
typedef short s16x4v __attribute__((ext_vector_type(4)));
__device__ __forceinline__ f32x4 mfma16(const v2u a, const v2u b, const f32x4 c) { return __builtin_amdgcn_mfma_f32_16x16x32_bf16(__builtin_bit_cast(bf16x8, ((v4u){a.x, a.y, 0u, 0u})), __builtin_bit_cast(bf16x8, ((v4u){b.x, b.y, 0u, 0u})), c, 0, 0, 0); }
__device__ __forceinline__ f32x4 mfma32(const v4u a, const v4u b, const f32x4 c) { return __builtin_amdgcn_mfma_f32_16x16x32_bf16(__builtin_bit_cast(bf16x8, a), __builtin_bit_cast(bf16x8, b), c, 0, 0, 0); }
constexpr int SPL_IMG = 16 * 144, SPL_KPT = 5 * SPL_IMG, SPL_AL = SPL_KPT + 64 * 40, SPL_TI = SPL_AL + 1024, SPL_WAVE = SPL_TI + 512;
static_assert(8 * SPL_WAVE + 8 * 512 <= RING_BYTES, "scan precompute LDS");
struct SpRaw { v4u a[5][2]; };
__device__ __forceinline__ void sp_fetch(SpRaw& o, Frame& F, int it, int lane) {
    const int head8 = it >> 11, b = (it >> 7) & 15, chunk = it & 127; const bool rw = head8 < 4; const int hd = head8 & 3;
    const size_t m0 = (size_t)b * T + chunk * 16; const int rowi = lane >> 3, c8 = lane & 7;
    if (rw) { const bf16* cr = (const bf16*)(F.ws + WS_CR) + hd * 64 + c8 * 8; const bf16* lo = (const bf16*)(F.ws + WS_LO) + hd * 64 + c8 * 8;
#pragma unroll
        for (int j = 0; j < 2; ++j) { const size_t m = m0 + 8 * j + rowi;
            o.a[0][j] = *(const v4u*)(cr + m * 1024); o.a[1][j] = *(const v4u*)(cr + m * 1024 + 256); o.a[2][j] = *(const v4u*)(cr + m * 1024 + 512);
            o.a[3][j] = *(const v4u*)(lo + m * 768); o.a[4][j] = *(const v4u*)(lo + m * 768 + 256); }
    } else { const bf16* chh = (const bf16*)(F.ws + WS_CH) + hd * 64 + c8 * 8;
#pragma unroll
        for (int j = 0; j < 2; ++j) { const size_t m = m0 + 8 * j + rowi;
            o.a[0][j] = *(const v4u*)(chh + m * 1024); o.a[1][j] = *(const v4u*)(chh + m * 1024 + 256); o.a[2][j] = *(const v4u*)(chh + m * 1024 + 512); o.a[3][j] = o.a[0][j]; o.a[4][j] = o.a[0][j]; } }
}
template <bool RW>
__device__ __forceinline__ void sp_item(Frame& F, int L, LAS unsigned char* wl, int it, int b, int hd, int chunk, int lane) {
    LAS bf16* RpI = (LAS bf16*)wl; LAS bf16* KqI = (LAS bf16*)(wl + SPL_IMG); LAS bf16* AqI = (LAS bf16*)(wl + 2 * SPL_IMG); LAS bf16* KpI = (LAS bf16*)(wl + 3 * SPL_IMG); LAS bf16* UaI = (LAS bf16*)(wl + 4 * SPL_IMG);
    LAS unsigned char* KpT = wl + SPL_KPT; LAS float* AL = (LAS float*)(wl + SPL_AL); LAS bf16* TI = (LAS bf16*)(wl + SPL_TI);
    const bf16* cr = (const bf16*)(F.ws + WS_CR);
    bf16* gRp = (bf16*)(F.ws + SP_RP); bf16* gKqT = (bf16*)(F.ws + SP_KQT); bf16* gE = (bf16*)(F.ws + SP_E); float* gPC = (float*)(F.ws + SP_PC); float* gBS = (float*)(F.ws + SP_BS);
    bf16* gVT = (bf16*)(F.ws + SP_VT); bf16* gK2 = (bf16*)(F.ws + SP_K2); bf16* gTB = (bf16*)(F.ws + SP_TB); bf16* gFm = (bf16*)(F.ws + SP_FM); bf16* gAqT = (bf16*)(F.ws + SP_AQT);
    const int row = lane & 15, g = lane >> 4, ch = hd * 64 + lane; (void)it; (void)UaI; (void)KpI; (void)KpT; (void)AL; (void)TI; (void)gBS; (void)gK2; (void)gTB; (void)gFm; (void)gAqT; (void)cr;
    const size_t m0 = (size_t)b * T + chunk * 16; const int ridx = (b * 4 + hd) * 128 + chunk, cidx = (b * 8 + (RW ? hd : 4 + hd)) * 128 + chunk; (void)ridx;
        float mur = 0.f, muk = 0.f, muv = 0.f, kkp = 0.f, kap_ = 0.f, rkp = 0.f, lb = 0.f;
        float pr = 0.f, pk = 0.f, pv = 0.f;
        if (RW) { mur = AIN(I_MU)[L * 1024 + ch]; muk = AIN(I_MU)[L * 1024 + 256 + ch]; muv = AIN(I_MU)[L * 1024 + 512 + ch]; kkp = AIN(I_KK)[L * 256 + ch]; kap_ = AIN(I_KA)[L * 256 + ch]; rkp = AIN(I_RK)[L * 256 + ch];
            if (chunk > 0) { pr = bf2f(cr[(m0 - 1) * 1024 + ch]); pk = bf2f(cr[(m0 - 1) * 1024 + 256 + ch]); pv = bf2f(cr[(m0 - 1) * 1024 + 512 + ch]); } }
        if (!RW && L == 1) lb = sigmoidf_(AIN(I_LB)[256 + ch] - AIN(I_LB)[ch]);
        asm volatile("s_waitcnt lgkmcnt(0)" ::: "memory");
        float P = 1.0f, bsv = 0.f;
        unsigned kqT[8], aqT[8], vT[8], kpT[8];
#pragma unroll
        for (int t = 0; t < 16; ++t) {
            float r, w, kq_, v, kap, at;
            const float x0 = bf2f(RpI[t * 72 + lane]), x1 = bf2f(KqI[t * 72 + lane]), x2 = bf2f(AqI[t * 72 + lane]);
            if (RW) { const float c_r = x0, c_k = x1, c_v = x2; const float uw = bf2f(KpI[t * 72 + lane]), ua = bf2f(UaI[t * 72 + lane]);
                r = c_r + (pr - c_r) * mur; const float k = c_k + (pk - c_k) * muk; v = c_v + (pv - c_v) * muv; pr = c_r; pk = c_k; pv = c_v;
                w = fexp(-0.6065306597126334f * sigmoidf_(uw)); const float aa = sigmoidf_(ua);
                const float kk = k * kkp; kap = kk * fminf(__builtin_amdgcn_rsqf(wave_sum_dpp(kk * kk)), 1e12f);
                kq_ = k * (1.0f + (aa - 1.0f) * kap_); at = kap * aa;
                const float bs = wave_sum_dpp(r * kq_ * rkp); bsv = (lane == t) ? bs : bsv; }
            else { r = siluf_(x0); w = lb + (1.0f - lb) * sigmoidf_(x1); kq_ = 1.0f - w; v = x2; kap = 0.f; at = 0.f; }
            const float Pm1 = P; P = fmaxf(P * w, 1e-30f); const float iP = frcp(P);
            const unsigned w0_ = cvt_pk_bf16(r * P, kap * Pm1), w1_ = cvt_pk_bf16(kq_ * iP, at * iP), w2_ = cvt_pk_bf16(v, 0.f);
            const unsigned rp_b = w0_ & 0xffffu, kp_b = w0_ >> 16, kq_b = w1_ & 0xffffu, aq_b = w1_ >> 16, v_b = w2_ & 0xffffu;
            RpI[t * 72 + lane] = (bf16)rp_b; KqI[t * 72 + lane] = (bf16)kq_b;
            if (RW) { KpI[t * 72 + lane] = (bf16)kp_b; AqI[t * 72 + lane] = (bf16)aq_b; }
            if (t & 1) { kqT[t >> 1] |= kq_b << 16; aqT[t >> 1] |= aq_b << 16; vT[t >> 1] |= v_b << 16; kpT[t >> 1] |= kp_b << 16; }
            else { kqT[t >> 1] = kq_b; aqT[t >> 1] = aq_b; vT[t >> 1] = v_b; kpT[t >> 1] = kp_b; }
        }
        asm volatile("" ::: "memory");
        gPC[(size_t)cidx * 64 + lane] = P;
        const unsigned fto = (unsigned)((lane >> 4) * 512 + (lane & 15) * 8);
#pragma unroll
        for (int gq = 0; gq < 4; ++gq) { *(v2u*)((char*)gKqT + (size_t)cidx * 2048 + fto + 128 * gq) = (v2u){kqT[2 * gq], kqT[2 * gq + 1]}; *(v2u*)((char*)gVT + (size_t)cidx * 2048 + fto + 128 * gq) = (v2u){vT[2 * gq], vT[2 * gq + 1]}; }
#pragma unroll
        for (int pr = 0; pr < 2; ++pr) { const v2u a_ = *(const LAS v2u*)((const LAS unsigned char*)RpI + row * 144 + (32 * pr + 4 * g) * 2), b_ = *(const LAS v2u*)((const LAS unsigned char*)RpI + row * 144 + (32 * pr + 16 + 4 * g) * 2);
            *(v4u*)((char*)gRp + (size_t)cidx * 2048 + pr * 1024 + lane * 16) = (v4u){a_.x, a_.y, b_.x, b_.y}; }
        v4u rpA[2], kqB[2];
#pragma unroll
        for (int s = 0; s < 2; ++s) { rpA[s] = *(const LAS v4u*)((const LAS unsigned char*)RpI + row * 144 + (8 * g + 32 * s) * 2); kqB[s] = *(const LAS v4u*)((const LAS unsigned char*)KqI + row * 144 + (8 * g + 32 * s) * 2); }
        f32x4 Em = (f32x4){0.f, 0.f, 0.f, 0.f}; Em = mfma32(rpA[0], kqB[0], Em); Em = mfma32(rpA[1], kqB[1], Em);
        LAS unsigned short* fimg = (LAS unsigned short*)(F.lds + 8 * SPL_WAVE + F.wave * 512);
#define SP_PUT16(gdst, idx512, expr) do { _Pragma("unroll") for (int q = 0; q < 4; ++q) fimg[((row >> 2) * 16 + 4 * g + q) * 4 + (row & 3)] = (unsigned short)f2bf(expr); \
        asm volatile("s_waitcnt lgkmcnt(0)" ::: "memory"); const v2u w_ = *(const LAS v2u*)((const LAS unsigned char*)fimg + lane * 8); asm volatile("s_waitcnt lgkmcnt(0)" ::: "memory"); \
        *(v2u*)((char*)(gdst) + (size_t)(idx512) * 512 + lane * 8) = w_; } while (0)
        SP_PUT16(gE, cidx, (row <= 4 * g + q) ? Em[q] : 0.f);
        if (RW) {
            if (lane < 16) gBS[(size_t)ridx * 16 + lane] = bsv;
#pragma unroll
            for (int gq = 0; gq < 4; ++gq) *(v2u*)((char*)gAqT + (size_t)ridx * 2048 + fto + 128 * gq) = (v2u){aqT[2 * gq], aqT[2 * gq + 1]};
#pragma unroll
            for (int q = 0; q < 4; ++q) *(LAS v2u*)(KpT + lane * 40 + q * 8) = (v2u){kpT[2 * q], kpT[2 * q + 1]};
            asm volatile("" ::: "memory");
            v4u kpA[2], aqB[2];
#pragma unroll
            for (int s = 0; s < 2; ++s) { kpA[s] = *(const LAS v4u*)((const LAS unsigned char*)KpI + row * 144 + (8 * g + 32 * s) * 2); aqB[s] = *(const LAS v4u*)((const LAS unsigned char*)AqI + row * 144 + (8 * g + 32 * s) * 2); }
            f32x4 Am = (f32x4){0.f, 0.f, 0.f, 0.f}, Bm = Am, Fmm = Am;
            Am = mfma32(kpA[0], aqB[0], Am); Am = mfma32(kpA[1], aqB[1], Am);
            Bm = mfma32(kpA[0], kqB[0], Bm); Bm = mfma32(kpA[1], kqB[1], Bm);
            Fmm = mfma32(rpA[0], aqB[0], Fmm); Fmm = mfma32(rpA[1], aqB[1], Fmm);
#pragma unroll
            for (int q = 0; q < 4; ++q) { const int t = 4 * g + q; Am[q] = (row < t) ? Am[q] : 0.f; Bm[q] = (row < t) ? Bm[q] : 0.f; AL[t * 16 + row] = Am[q]; }
            SP_PUT16(gFm, ridx, (row <= 4 * g + q) ? Fmm[q] : 0.f);
            asm volatile("" ::: "memory");
            float Tc[16];
#pragma unroll
            for (int t = 0; t < 16; ++t) { float acc = (row == t) ? 1.0f : 0.f;
                f32x4 ar[4];
#pragma unroll
                for (int q = 0; q < 4; ++q) ar[q] = *(const LAS f32x4*)(AL + t * 16 + 4 * q);
#pragma unroll
                for (int i = 0; i < 16; ++i) if (i < t) acc -= ar[i >> 2][i & 3] * Tc[i];
                Tc[t] = acc; TI[t * 16 + row] = (bf16)f2bf(acc); }
            asm volatile("" ::: "memory");
            const v2u tB = *(const LAS v2u*)((const LAS unsigned char*)TI + row * 32 + g * 8);
#pragma unroll
            for (int pr = 0; pr < 2; ++pr) { const v2u ka = *(const LAS v2u*)(KpT + (32 * pr + row) * 40 + g * 8), kb2 = *(const LAS v2u*)(KpT + (32 * pr + 16 + row) * 40 + g * 8);
                const f32x4 d = mfma16(ka, tB, (f32x4){0.f, 0.f, 0.f, 0.f}), d2 = mfma16(kb2, tB, (f32x4){0.f, 0.f, 0.f, 0.f});
                *(v4u*)((char*)gK2 + (size_t)ridx * 2048 + pr * 1024 + lane * 16) = (v4u){pk2(d[0], d[1]), pk2(d[2], d[3]), pk2(d2[0], d2[1]), pk2(d2[2], d2[3])}; }
            { const v2u bB = (v2u){pk2(Bm[0], Bm[1]), pk2(Bm[2], Bm[3])};
              const f32x4 d = mfma16(tB, bB, (f32x4){0.f, 0.f, 0.f, 0.f});
              SP_PUT16(gTB, ridx, d[q]); }
#undef SP_PUT16
        }
        asm volatile("s_waitcnt lgkmcnt(0)" ::: "memory");
}
__device__ __forceinline__ void p_scanpre(Frame& F, int L) {
    LAS unsigned char* wl = F.lds + F.wave * SPL_WAVE;
    LAS bf16* RpI = (LAS bf16*)wl; LAS bf16* KqI = (LAS bf16*)(wl + SPL_IMG); LAS bf16* AqI = (LAS bf16*)(wl + 2 * SPL_IMG); LAS bf16* KpI = (LAS bf16*)(wl + 3 * SPL_IMG); LAS bf16* UaI = (LAS bf16*)(wl + 4 * SPL_IMG);
    LAS unsigned char* KpT = wl + SPL_KPT; LAS float* AL = (LAS float*)(wl + SPL_AL); LAS bf16* TI = (LAS bf16*)(wl + SPL_TI);
    const bf16* cr = (const bf16*)(F.ws + WS_CR);
    bf16* gRp = (bf16*)(F.ws + SP_RP); bf16* gKqT = (bf16*)(F.ws + SP_KQT); bf16* gE = (bf16*)(F.ws + SP_E); float* gPC = (float*)(F.ws + SP_PC); float* gBS = (float*)(F.ws + SP_BS);
    bf16* gVT = (bf16*)(F.ws + SP_VT); bf16* gK2 = (bf16*)(F.ws + SP_K2); bf16* gTB = (bf16*)(F.ws + SP_TB); bf16* gFm = (bf16*)(F.ws + SP_FM); bf16* gAqT = (bf16*)(F.ws + SP_AQT);
    const int lane = F.lane, row = lane & 15, g = lane >> 4;
    const int gw = F.vcu * NWAVES + F.wave, NGW = F.G * NWAVES;
#define SP_HT(x) ((((x) & 7) >> 1) + 4 * ((x) & 1))
    SpRaw raw; sp_fetch(raw, F, SP_HT(F.wave) * 2048 + gw, lane);
    for (int k = 0; k < 16384 / NGW; ++k) {
        const int it = SP_HT(k + F.wave) * 2048 + gw, itn = SP_HT(k + 1 + F.wave) * 2048 + gw;
        const int head8 = it >> 11, b = (it >> 7) & 15, chunk = it & 127;
        { const int so = (lane >> 3) * 144 + (lane & 7) * 16;
#pragma unroll
          for (int i = 0; i < 5; ++i)
#pragma unroll
              for (int j = 0; j < 2; ++j) *(LAS v4u*)(wl + i * SPL_IMG + j * 8 * 144 + so) = raw.a[i][j]; }
        if (k + 1 < 16384 / NGW) sp_fetch(raw, F, itn, lane);
        if (head8 < 4) sp_item<true>(F, L, wl, it, b, head8, chunk, lane); else sp_item<false>(F, L, wl, it, b, head8 - 4, chunk, lane);
    }
}
constexpr int RC_RP = 0, RC_K2 = 2048, RC_KQT = 4096, RC_AQT = 6144, RC_VT = 8192, RC_E = 10240, RC_TB = 10752, RC_FM = 11264, RC_PC = 11776, RC_BS = 12032, RC_GT = 12288, RC_BYTES = 14336;
constexpr int SS_NSLOT = 8, SS_DEPTH = 6, SS_XCH = SS_NSLOT * RC_BYTES;
static_assert(SS_XCH + 8192 + 8192 <= RING_BYTES, "scan ring LDS");
#define SS_BARRIER() do { asm volatile("s_waitcnt lgkmcnt(0)" ::: "memory"); __builtin_amdgcn_s_barrier(); asm volatile("" ::: "memory"); } while (0)
template <bool RW>
__device__ __forceinline__ void ss_head(Frame& F, int L, int b, int hd) {
    const int lane = F.lane, row = lane & 15, g = lane >> 4, vs = F.wave & 3; const bool cons = F.wave < 4;
    const int vcol = vs * 16 + row, ch = hd * 64 + vcol;
    const int cbase = (b * 8 + (RW ? hd : 4 + hd)) * 128, rbase = (b * 4 + hd) * 128; const size_t mb = (size_t)b * T;
    LAS unsigned char* ring = F.lds; LAS float* xch = (LAS float*)(F.lds + SS_XCH);
    LAS unsigned char* ytile = F.lds + SS_XCH + 8192;
    if (!cons) {
        const int ll = (F.wave - 4) * 64 + lane;
        const char* src[4]; unsigned stride[4]; bool on[4];
        {
          if (ll < 128) { src[0] = (const char*)(F.ws + SP_RP) + (size_t)cbase * 2048 + ll * 16; stride[0] = 2048; on[0] = true; }
          else { src[0] = (const char*)(F.ws + SP_K2) + (size_t)rbase * 2048 + (ll - 128) * 16; stride[0] = 2048; on[0] = RW; }
          if (ll < 128) { src[1] = (const char*)(F.ws + SP_KQT) + (size_t)cbase * 2048 + ll * 16; stride[1] = 2048; on[1] = true; }
          else { src[1] = (const char*)(F.ws + SP_AQT) + (size_t)rbase * 2048 + (ll - 128) * 16; stride[1] = 2048; on[1] = RW; }
          if (ll < 128) { src[2] = (const char*)(F.ws + SP_VT) + (size_t)cbase * 2048 + ll * 16; stride[2] = 2048; on[2] = true; }
          else if (ll < 160) { src[2] = (const char*)(F.ws + SP_E) + (size_t)cbase * 512 + (ll - 128) * 16; stride[2] = 512; on[2] = true; }
          else if (ll < 192) { src[2] = (const char*)(F.ws + SP_TB) + (size_t)rbase * 512 + (ll - 160) * 16; stride[2] = 512; on[2] = RW; }
          else if (ll < 224) { src[2] = (const char*)(F.ws + SP_FM) + (size_t)rbase * 512 + (ll - 192) * 16; stride[2] = 512; on[2] = RW; }
          else if (ll < 240) { src[2] = (const char*)(F.ws + SP_PC) + (size_t)cbase * 256 + (ll - 224) * 16; stride[2] = 256; on[2] = true; }
          else if (ll < 244) { src[2] = (const char*)(F.ws + SP_BS) + (size_t)rbase * 64 + (ll - 240) * 16; stride[2] = 64; on[2] = RW; }
          else { src[2] = (const char*)(F.ws + SP_PC); stride[2] = 0; on[2] = false; }
          if (ll < 128) { const int r = ll >> 3, c16 = ll & 7;
              src[3] = RW ? (const char*)(F.ws + WS_LO) + (mb + r) * 1536 + 1024 + hd * 128 + c16 * 16 : (const char*)(F.ws + WS_CH) + (mb + r) * 2048 + 1536 + hd * 128 + c16 * 16;
              stride[3] = RW ? 16 * 1536 : 16 * 2048; on[3] = true; }
          else { src[3] = (const char*)(F.ws + SP_PC); stride[3] = 0; on[3] = false; } }
        (void)on;
        const int lw = F.wave - 4, nj = (lw < 2) ? 4 : 3;
        bf16* y = (bf16*)(F.ws + WS_H);
        LAS unsigned short* otile = (LAS unsigned short*)(F.lds + SS_XCH + 4096 + vs * 512);
        float p0 = 0.f, p1 = 0.f;
        if (RW) { p0 = AIN(I_LNW)[L * 256 + ch]; p1 = AIN(I_LNB)[L * 256 + ch]; } else p0 = AIN(I_GN)[L * 256 + ch];
        const unsigned l8o = (unsigned)lane * 8u;
        auto out_stage = [&](int c) {
            const LAS unsigned char* rec = ring + (c % SS_NSLOT) * RC_BYTES;
            const f32x4 Yp = *(const LAS f32x4*)(ytile + (((c & 1) * 4 + vs) * 64 + lane) * 16);
            const v2u vtp = *(const LAS v2u*)(rec + RC_VT + 512 * vs + l8o);
            f32x4 bsp = (f32x4){0.f, 0.f, 0.f, 0.f}; if (RW) bsp = *(const LAS f32x4*)(rec + RC_BS + 16 * g);
            float vv[4]; unpk4(vtp, vv);
#pragma unroll
            for (int q = 0; q < 4; ++q) { const int t = 4 * g + q; float t1 = 0.f, t2 = 0.f;
                const unsigned short gtq = *(const LAS unsigned short*)(rec + RC_GT + t * 128 + vcol * 2);
#pragma unroll
                for (int w = 0; w < 4; ++w) { const f32x2 x = *(const LAS f32x2*)(xch + (((c & 1) * 4 + w) * 16 + t) * 2); t1 += x.x; t2 += x.y; }
                const float gate = bf2f(gtq); float o;
                if (RW) { const float mean = t1 * (1.f / 64.f), var = t2 * (1.f / 64.f) - mean * mean;
                    o = ((Yp[q] - mean) * __builtin_amdgcn_rsqf(fmaxf(var, 0.f) + 64e-5f) * p0 + p1 + bsp[q] * vv[q]) * gate; }
                else o = Yp[q] * __builtin_amdgcn_rsqf(t2 * (1.f / 64.f) + 1e-6f) * p0 * siluf_(gate);
                otile[t * 16 + row] = (unsigned short)f2bf(o); }
            asm volatile("s_waitcnt lgkmcnt(0)" ::: "memory");
            const v2u ov = *(const LAS v2u*)((const LAS unsigned char*)otile + lane * 8);
            asm volatile("s_waitcnt lgkmcnt(0)" ::: "memory");
            *(v2u*)(y + (mb + (size_t)c * 16 + (lane >> 2)) * 1024 + (RW ? 0 : 768) + hd * 64 + vs * 16 + 4 * (lane & 3)) = ov;
        };
        auto issue = [&](int k) { const int kk = k < 128 ? k : 127; LAS unsigned char* slot = ring + (k % SS_NSLOT) * RC_BYTES + lw * 1024;
#pragma unroll
            for (int j = 0; j < 4; ++j) if (j < nj) __builtin_amdgcn_global_load_lds((const unsigned*)(src[j] + (size_t)kk * stride[j]), (LAS unsigned*)(slot + j * 4096), 16, 0, 0); };
        for (int k = 0; k < SS_DEPTH; ++k) issue(k);
        if (nj == 4) asm volatile("s_waitcnt vmcnt(%0)" :: "n"((SS_DEPTH - 1) * 4) : "memory"); else asm volatile("s_waitcnt vmcnt(%0)" :: "n"((SS_DEPTH - 1) * 3) : "memory");
        SS_BARRIER();
#pragma unroll 1
        for (int c = 0; c < 128; ++c) {
            issue(c + SS_DEPTH);
            if (c > 0) out_stage(c - 1);
            if (nj == 4) asm volatile("s_waitcnt vmcnt(%0)" :: "n"((SS_DEPTH - 1) * 4) : "memory"); else asm volatile("s_waitcnt vmcnt(%0)" :: "n"((SS_DEPTH - 1) * 3) : "memory");
            SS_BARRIER(); }
        out_stage(127);
        asm volatile("s_waitcnt vmcnt(0)" ::: "memory");
        return;
    }
    f32x4 S[4];
#pragma unroll
    for (int i = 0; i < 4; ++i) S[i] = (f32x4){0.f, 0.f, 0.f, 0.f};
    const unsigned l8 = (unsigned)lane * 8u;
    SS_BARRIER();
#pragma unroll 1
    for (int c = 0; c < 128; ++c) {
        const LAS unsigned char* rec = ring + (c % SS_NSLOT) * RC_BYTES;
        v4u rpp[2], k2p[2]; v2u kqt[4], aqt[4]; f32x4 pc[4];
#pragma unroll
        for (int i = 0; i < 4; ++i) { kqt[i] = *(const LAS v2u*)(rec + RC_KQT + 512 * i + l8); pc[i] = *(const LAS f32x4*)(rec + RC_PC + 64 * i + 16 * g);
            if (RW) aqt[i] = *(const LAS v2u*)(rec + RC_AQT + 512 * i + l8); }
#pragma unroll
        for (int pr = 0; pr < 2; ++pr) { rpp[pr] = *(const LAS v4u*)(rec + RC_RP + 1024 * pr + 2 * l8); if (RW) k2p[pr] = *(const LAS v4u*)(rec + RC_K2 + 1024 * pr + 2 * l8); }
        const v2u e_ = *(const LAS v2u*)(rec + RC_E + l8), vt = *(const LAS v2u*)(rec + RC_VT + 512 * vs + l8);
        f32x4 Y = (f32x4){0.f, 0.f, 0.f, 0.f}, Z = Y;
        const v4u sb0 = (v4u){cvt_pk_bf16(S[0][0], S[0][1]), cvt_pk_bf16(S[0][2], S[0][3]), cvt_pk_bf16(S[1][0], S[1][1]), cvt_pk_bf16(S[1][2], S[1][3])};
        const v4u sb1 = (v4u){cvt_pk_bf16(S[2][0], S[2][1]), cvt_pk_bf16(S[2][2], S[2][3]), cvt_pk_bf16(S[3][0], S[3][1]), cvt_pk_bf16(S[3][2], S[3][3])};
        Y = mfma32(rpp[0], sb0, Y); Y = mfma32(rpp[1], sb1, Y);
        Y = mfma16(e_, vt, Y);
        v2u zn = (v2u){0u, 0u};
        if (RW) { const v2u tb = *(const LAS v2u*)(rec + RC_TB + l8), fm = *(const LAS v2u*)(rec + RC_FM + l8);
            Z = mfma32(k2p[0], sb0, Z); Z = mfma32(k2p[1], sb1, Z);
            Z = mfma16(tb, vt, Z);
            zn = (v2u){cvt_pk_bf16(-Z[0], -Z[1]), cvt_pk_bf16(-Z[2], -Z[3])};
            Y = mfma16(fm, zn, Y); }
        *(LAS f32x4*)(ytile + (((c & 1) * 4 + vs) * 64 + lane) * 16) = Y;
#pragma unroll
        for (int q = 0; q < 4; ++q) { const float s1 = row16_sum(Y[q]), s2 = row16_sum(Y[q] * Y[q]);
            if (row == 0) *(LAS f32x2*)(xch + (((c & 1) * 4 + vs) * 16 + 4 * g + q) * 2) = (f32x2){s1, s2}; }
#pragma unroll
        for (int tile = 0; tile < 4; ++tile) { f32x4 d = mfma16(kqt[tile], vt, S[tile]); if (RW) d = mfma16(aqt[tile], zn, d); S[tile] = d * pc[tile]; }
        SS_BARRIER();
    }
}
__device__ __forceinline__ void p_scanseq(Frame& F, int L, int mode) {
    const int pair = F.vcu; if (pair < 128 && (mode & 1)) return; if (pair >= 128 && (mode & 2)) return; if (pair >= 128) { if (L == 0) p_moe_weights2(F); else { Frame G2 = F; G2.vcu = F.vcu - 128; G2.G = 128; p_moe_weights(F, G2, 2, NEXP); } return; }
    const int b = pair >> 3, head8 = pair & 7;
    if (head8 < 4) ss_head<true>(F, L, b, head8); else ss_head<false>(F, L, b, head8 - 4);
}

constexpr int AT_KSTRB = 208, AT_VSTRB = 192;
constexpr int AT_KB = 64 * AT_KSTRB, AT_VB = 64 * AT_VSTRB, AT_BUF = AT_KB + AT_VB;
static_assert(2 * AT_BUF <= RING_BYTES, "attention LDS");
typedef short v4i16_t __attribute__((ext_vector_type(4)));
__device__ __forceinline__ int crow(int r) { return (r & 3) + 8 * (r >> 2); }
__device__ __forceinline__ bf16x8 scale_frag(bf16x8 q, float c) { v4u w = __builtin_bit_cast(v4u, q); v4u o;
    o.x = cvt_pk_bf16(bflo(w.x) * c, bfhi(w.x) * c); o.y = cvt_pk_bf16(bflo(w.y) * c, bfhi(w.y) * c); o.z = cvt_pk_bf16(bflo(w.z) * c, bfhi(w.z) * c); o.w = cvt_pk_bf16(bflo(w.w) * c, bfhi(w.w) * c);
    return __builtin_bit_cast(bf16x8, o); }
template <int DQ, bool DIL>
__device__ __forceinline__ void attn_unit(Frame& F, const bf16* Qp, int ldq, const bf16* K1, int ldk1, const bf16* K2, int ldk2, const bf16* Vp, int ldv, bf16* Op, int ldo, int q0, float c1) {
    constexpr int NS = DQ / 16;
    int tid_ = F.tid; asm volatile("" : "+v"(tid_));
    const int tid = tid_, lane = tid & 63, r = lane & 31, h = lane >> 5, wid = F.wave;
    const int qi = q0 + wid * 32 + r;
    bf16x8 qr[NS];
#pragma unroll
    for (int s = 0; s < NS; ++s) qr[s] = scale_frag(*(const bf16x8*)(Qp + (size_t)qi * ldq + 16 * s + 8 * h), c1);
    f32x16 o0, o1;
#pragma unroll
    for (int i = 0; i < 16; ++i) { o0[i] = 0.f; o1[i] = 0.f; }
    float mrun = -1.0e30f, lrun = 0.f;
    const int ntile = (q0 + 256) / 64; const int qlo = q0 + wid * 32, qhi = qlo + 31;
    const int skey = tid >> 3, sc = tid & 7, skey2 = tid >> 2, sc2 = tid & 3;
    const int li = lane & 15, tq = li >> 2, tp = li & 3, tg = (lane >> 4) & 1;
    const int vtoff = (4 * h + tq) * AT_VSTRB + (16 * tg + 4 * tp) * 2;
    v4u gk, gk2 = (v4u){0, 0, 0, 0}, gv;
    gk = *(const v4u*)(K1 + (size_t)skey * ldk1 + sc * 8); gv = *(const v4u*)(Vp + (size_t)skey * ldv + sc * 8);
    if (DQ == 96 && tid < 256) gk2 = *(const v4u*)(K2 + (size_t)skey2 * ldk2 + sc2 * 8);
    const int dres = qi - 4 * h, j0_ = dres & 3, q4_ = (dres - j0_) & 15;
    bool dB[4], dC[4][2];
#pragma unroll
    for (int j = 0; j < 4; ++j) { dB[j] = DIL && (j0_ == j); dC[j][0] = dB[j] && (q4_ == 0); dC[j][1] = dB[j] && (q4_ == 8); }
    __syncthreads();
    for (int t = 0; t < ntile; ++t) {
        const int k0 = t * 64;
        LAS unsigned char* kb_ = F.lds + (t & 1) * AT_BUF; LAS unsigned char* vb_ = kb_ + AT_KB;
        *(LAS v4u*)(kb_ + skey * AT_KSTRB + sc * 16) = gk;
        if (DQ == 96 && tid < 256) *(LAS v4u*)(kb_ + skey2 * AT_KSTRB + 128 + sc2 * 16) = gk2;
        *(LAS v4u*)(vb_ + skey * AT_VSTRB + sc * 16) = gv;
        __syncthreads();
        if (t + 1 < ntile) { const size_t kn = (size_t)(k0 + 64);
            gk = *(const v4u*)(K1 + (kn + skey) * ldk1 + sc * 8); gv = *(const v4u*)(Vp + (kn + skey) * ldv + sc * 8);
            if (DQ == 96 && tid < 256) gk2 = *(const v4u*)(K2 + (kn + skey2) * ldk2 + sc2 * 8); }
        if (k0 > qhi) continue;
        f32x16 p[2];
#pragma unroll
        for (int kb = 0; kb < 2; ++kb) {
            bf16x8 kf[NS];
#pragma unroll
            for (int s = 0; s < NS; ++s) kf[s] = *(const LAS bf16x8*)(kb_ + (kb * 32 + r) * AT_KSTRB + (16 * s + 8 * h) * 2);
            asm volatile("s_waitcnt lgkmcnt(0)" ::: "memory");
#pragma unroll
            for (int i = 0; i < 16; ++i) p[kb][i] = 0.f;
#pragma unroll
            for (int s = 0; s < NS; ++s) p[kb] = __builtin_amdgcn_mfma_f32_32x32x16_bf16(kf[s], qr[s], p[kb], 0, 0, 0);
        }
        v4i16_t vf[2][2][4];
#pragma unroll
        for (int kb = 0; kb < 2; ++kb)
#pragma unroll
            for (int s2 = 0; s2 < 2; ++s2) { const LAS unsigned char* vp = vb_ + (kb * 32 + 16 * s2) * AT_VSTRB + vtoff;
                vf[kb][s2][0] = __builtin_amdgcn_ds_read_tr16_b64_v4i16((LAS v4i16_t*)(vp)); vf[kb][s2][1] = __builtin_amdgcn_ds_read_tr16_b64_v4i16((LAS v4i16_t*)(vp + 8 * AT_VSTRB));
                vf[kb][s2][2] = __builtin_amdgcn_ds_read_tr16_b64_v4i16((LAS v4i16_t*)(vp + 64)); vf[kb][s2][3] = __builtin_amdgcn_ds_read_tr16_b64_v4i16((LAS v4i16_t*)(vp + 64 + 8 * AT_VSTRB)); }
        const int dbase = qi - k0 - 4 * h;
        const int dmin = qlo - (k0 + 63);
        const int dmax = qhi - k0;
        if (DIL) {
            if (dmin > 512) {
#pragma unroll
                for (int kb = 0; kb < 2; ++kb)
#pragma unroll
                    for (int i = 0; i < 16; ++i) p[kb][i] = dC[i & 3][(i >> 2) & 1] ? p[kb][i] : -INFINITY;
            } else if (dmin > 128 && dmax <= 512) {
#pragma unroll
                for (int kb = 0; kb < 2; ++kb)
#pragma unroll
                    for (int i = 0; i < 16; ++i) { const float x = p[kb][i]; p[kb][i] = dC[i & 3][(i >> 2) & 1] ? x + 1.0f : (dB[i & 3] ? x : -INFINITY); }
            } else if (dmin >= 0 && dmax <= 128) {
#pragma unroll
                for (int kb = 0; kb < 2; ++kb)
#pragma unroll
                    for (int i = 0; i < 16; ++i) { const float x = p[kb][i]; p[kb][i] = dC[i & 3][(i >> 2) & 1] ? x + 1.5849625007211562f : (dB[i & 3] ? x + 1.0f : x); }
            } else if (dmin > 128) {
#pragma unroll
                for (int kb = 0; kb < 2; ++kb)
#pragma unroll
                    for (int i = 0; i < 16; ++i) { const int dl = dbase - 32 * kb - crow(i); const bool le = dl <= 512;
                        const float tC = le ? 1.0f : 0.0f, tB = le ? 0.0f : -INFINITY;
                        p[kb][i] += dC[i & 3][(i >> 2) & 1] ? tC : (dB[i & 3] ? tB : -INFINITY); }
            } else {
#pragma unroll
                for (int kb = 0; kb < 2; ++kb)
#pragma unroll
                    for (int i = 0; i < 16; ++i) { const int dl = dbase - 32 * kb - crow(i); const bool a = (unsigned)dl <= 128u;
                        const float t0 = a ? 0.0f : -INFINITY, tB = a ? 1.0f : 0.0f, tC = a ? 1.5849625007211562f : 1.0f;
                        float bias = dC[i & 3][(i >> 2) & 1] ? tC : (dB[i & 3] ? tB : t0);
                        if (dmin < 0) bias = (dl < 0) ? -INFINITY : bias;
                        p[kb][i] += bias; }
            }
        } else if (dmin < 0) {
#pragma unroll
            for (int kb = 0; kb < 2; ++kb)
#pragma unroll
                for (int i = 0; i < 16; ++i) { const int dl = dbase - 32 * kb - crow(i); p[kb][i] = (dl < 0) ? -INFINITY : p[kb][i]; }
        }
        float mx = fmaxf(p[0][0], p[1][0]);
#pragma unroll
        for (int i = 1; i < 16; ++i) mx = fmaxf(mx, fmaxf(p[0][i], p[1][i]));
        mx = fmaxf(mx, __shfl_xor(mx, 32));
        const float mnew = fmaxf(mrun, mx);
        if (!__all(mnew == mrun)) { const float alpha = __builtin_amdgcn_exp2f(mrun - mnew); lrun *= alpha;
#pragma unroll
            for (int i = 0; i < 16; ++i) { o0[i] *= alpha; o1[i] *= alpha; } }
        mrun = mnew;
        float rsum = 0.f;
#pragma unroll
        for (int kb = 0; kb < 2; ++kb)
#pragma unroll
            for (int i = 0; i < 16; ++i) { const float e = __builtin_amdgcn_exp2f(p[kb][i] - mnew); p[kb][i] = e; rsum += e; }
        lrun += rsum;
        asm volatile("s_waitcnt lgkmcnt(0)" ::: "memory");
#pragma unroll
        for (int kb = 0; kb < 2; ++kb)
#pragma unroll
            for (int s2 = 0; s2 < 2; ++s2) {
                v4u pw; pw.x = cvt_pk_bf16(p[kb][8 * s2 + 0], p[kb][8 * s2 + 1]); pw.y = cvt_pk_bf16(p[kb][8 * s2 + 2], p[kb][8 * s2 + 3]);
                pw.z = cvt_pk_bf16(p[kb][8 * s2 + 4], p[kb][8 * s2 + 5]); pw.w = cvt_pk_bf16(p[kb][8 * s2 + 6], p[kb][8 * s2 + 7]);
                const bf16x8 pb = __builtin_bit_cast(bf16x8, pw);
                const v4i16_t a00 = vf[kb][s2][0], a01 = vf[kb][s2][1], a10 = vf[kb][s2][2], a11 = vf[kb][s2][3];
                const bf16x8 av0 = (bf16x8){a00[0], a00[1], a00[2], a00[3], a01[0], a01[1], a01[2], a01[3]};
                const bf16x8 av1 = (bf16x8){a10[0], a10[1], a10[2], a10[3], a11[0], a11[1], a11[2], a11[3]};
                o0 = __builtin_amdgcn_mfma_f32_32x32x16_bf16(av0, pb, o0, 0, 0, 0);
                o1 = __builtin_amdgcn_mfma_f32_32x32x16_bf16(av1, pb, o1, 0, 0, 0);
            }
    }
    lrun += __shfl_xor(lrun, 32);
    const float inv = frcp(lrun);
    bf16* orow = Op + (size_t)qi * ldo;
#pragma unroll
    for (int g = 0; g < 4; ++g) {
        v2u w0, w1; w0.x = pk2(o0[4 * g] * inv, o0[4 * g + 1] * inv); w0.y = pk2(o0[4 * g + 2] * inv, o0[4 * g + 3] * inv);
        w1.x = pk2(o1[4 * g] * inv, o1[4 * g + 1] * inv); w1.y = pk2(o1[4 * g + 2] * inv, o1[4 * g + 3] * inv);
        *(v2u*)(orow + 8 * g + 4 * h) = w0; *(v2u*)(orow + 32 + 8 * g + 4 * h) = w1;
    }
}
__device__ __forceinline__ void p_attn(Frame& F) {
    const int v = F.vcu, bh = v >> 2, s = v & 3, b = bh >> 2, hd = bh & 3; const size_t row0 = (size_t)b * T;
    const bf16* cd = (const bf16*)(F.ws + WS_CD) + row0 * 768 + hd * 64; const bf16* cm = (const bf16*)(F.ws + WS_CM) + row0 * 512 + 384;
    const bf16* qm = (const bf16*)(F.ws + WS_QM) + row0 * 384 + hd * 96; const bf16* kvm = (const bf16*)(F.ws + WS_KVM) + row0 * 512 + hd * 128;
    bf16* y = (bf16*)(F.ws + WS_H) + row0 * 1024;
    for (int i = 0; i < 2; ++i) { const int qb = i == 0 ? s : 7 - s;
        attn_unit<64, true>(F, cd, 768, cd + 256, 768, nullptr, 0, cd + 512, 768, y + 256 + hd * 64, 1024, qb * 256, 0.125f * 1.4426950408889634f);
        attn_unit<96, false>(F, qm, 384, kvm, 512, cm, 512, kvm + 64, 512, y + 512 + hd * 64, 1024, qb * 256, 0.10206207261596577f * 1.4426950408889634f); }
}

constexpr int PH_PRO = 0, PH_L = 12;
constexpr int PH_SCAT = 23, PH_UP0 = 24, PH_DN0 = 25, PH_UP1 = 26, PH_DN1 = 27, PH_FIN = 28, N_PHASES = 29;

#define PHASE_FN __device__ __forceinline__ void
#define ROPE_PTRS const float* cosd = (const float*)(F.ws + WS_ROPE); const float* sind = cosd + (size_t)M * 32; const float* cosm = sind + (size_t)M * 32; const float* sinm = cosm + (size_t)M * 16
PHASE_FN ph_prologue() { Frame F; frame_init(F); p_prologue(F); }
#define XB ((bf16*)(F.out + (size_t)M * D / 2))
PHASE_FN ph_norm1(int L) { Frame F; frame_init(F); L = __builtin_amdgcn_readfirstlane(L);
    if (L == 0) norm_rows(F, AIN(I_X), AIN(I_MIXN), (bf16*)(F.ws + WS_H)); else norm_rows_b(F, XB, AIN(I_MIXN) + L * D, (bf16*)(F.ws + WS_H)); }
PHASE_FN ph_gemm1(int L) { Frame F; frame_init(F); L = __builtin_amdgcn_readfirstlane(L); unsigned char* ws = F.ws; ROPE_PTRS;
    pg8::Gemm g{(const bf16*)(ws + WS_H), (const bf16*)(ws + WS_WIN) + (size_t)L * NINP * D, D, D, D}; pg8::StaticOrder S; S.init(M / 256, NINP / 256, F.G, (int)blockIdx.x);
    pg8::EpiCols E{(bf16*)(ws + WS_CR), (bf16*)(ws + WS_CD), (bf16*)(ws + WS_CM), (bf16*)(ws + WS_CH), cosd, sind, cosm, sinm};
    pg8::gemm_phase<pg8::EpiCols, pg8::StaticOrder>(F.lds, g, S, E);
    if ((int)blockIdx.x >= 128) { __syncthreads(); Frame G2 = F; G2.vcu = (int)blockIdx.x - 128; G2.G = 128;
        if (L == 0) p_blockmats(G2); else p_moe_weights(F, G2, 0, 2); } }
PHASE_FN ph_prepA(int L) { Frame F; frame_init(F); L = __builtin_amdgcn_readfirstlane(L); p_prepA(F, L); }
PHASE_FN ph_lora(int L) { Frame F; frame_init(F); L = __builtin_amdgcn_readfirstlane(L); unsigned char* ws = F.ws;
    pg8::Gemm g{(const bf16*)(ws + WS_AL), (const bf16*)(ws + WS_WLORA) + (size_t)L * 768 * 256, 256, 256, 256}; pg8::StaticOrder S; S.init(M / 256, 3, F.G, (int)blockIdx.x);
    pg8::EpiLora E{(bf16*)(ws + WS_LO), AIN(I_W0) + L * 256, AIN(I_A0) + L * 256};
    pg8::gemm_phase<pg8::EpiLora, pg8::StaticOrder>(F.lds, g, S, E); }
PHASE_FN ph_mla(int L) { Frame F; frame_init(F); L = __builtin_amdgcn_readfirstlane(L); unsigned char* ws = F.ws; ROPE_PTRS; (void)cosd; (void)sind;
    pg8::Gemm g{(const bf16*)(ws + WS_CM), (const bf16*)(ws + WS_WMLA) + (size_t)L * 1024 * 384, 384, 512, 384}; pg8::StaticOrder S; S.init(M / 256, 4, F.G, (int)blockIdx.x);
    pg8::EpiMla E{(bf16*)(ws + WS_QM), (bf16*)(ws + WS_KVM), (const float*)(ws + MS_RS), cosm, sinm};
    pg8::gemm_phase<pg8::EpiMla, pg8::StaticOrder>(F.lds, g, S, E); }
PHASE_FN ph_attn() { Frame F; frame_init(F); p_attn(F); }
PHASE_FN ph_scanpre(int L) { Frame F; frame_init(F); L = __builtin_amdgcn_readfirstlane(L); p_scanpre(F, L); }
PHASE_FN ph_scanseq(int L, int mode) { Frame F; frame_init(F); L = __builtin_amdgcn_readfirstlane(L); mode = __builtin_amdgcn_readfirstlane(mode); p_scanseq(F, L, mode); }
PHASE_FN ph_gemm2(int L) { Frame F; frame_init(F); L = __builtin_amdgcn_readfirstlane(L); unsigned char* ws = F.ws;
    pg8::Gemm g{(const bf16*)(ws + WS_H), (const bf16*)(ws + WS_WOUT) + (size_t)L * D * D, D, D, D}; pg8::StaticOrder S; S.init(M / 256, 4, F.G, (int)blockIdx.x);
    pg8::EpiResid E{L == 0 ? AIN(I_X) : (const float*)nullptr, XB, XB};
    pg8::gemm_phase<pg8::EpiResid, pg8::StaticOrder>(F.lds, g, S, E); }
PHASE_FN ph_norm2d() { Frame F; frame_init(F); norm_rows_b(F, XB, AIN(I_FFNN), (bf16*)(F.ws + WS_H)); }
PHASE_FN ph_up_dense() { Frame F; frame_init(F); unsigned char* ws = F.ws;
    pg8::Gemm g{(const bf16*)(ws + WS_H), (const bf16*)(ws + WS_W13D), D, D, D}; pg8::StaticOrder S; S.init(M / 256, 2 * FF / 256, F.G, (int)blockIdx.x);
    pg8::EpiSwiglu E{(bf16*)(ws + WS_ACT), FF};
    pg8::gemm_phase<pg8::EpiSwiglu, pg8::StaticOrder>(F.lds, g, S, E); }
PHASE_FN ph_down_dense() { Frame F; frame_init(F); unsigned char* ws = F.ws;
    pg8::Gemm g{(const bf16*)(ws + WS_ACT), (const bf16*)(ws + WS_W2D), FF, FF, FF}; pg8::StaticOrder S; S.init(M / 256, 4, F.G, (int)blockIdx.x);
    pg8::EpiResid E{(const float*)nullptr, XB, XB};
    pg8::gemm_phase<pg8::EpiResid, pg8::StaticOrder>(F.lds, g, S, E); }
PHASE_FN ph_norm_router() { Frame F; frame_init(F); norm_router(F, XB, AIN(I_FFNN) + D, AIN(I_RT), (bf16*)(F.ws + WS_H)); }
PHASE_FN ph_scatter() { Frame F; frame_init(F); moe_scatter(F); }
PHASE_FN ph_moe_up(int s) { Frame F; frame_init(F); s = __builtin_amdgcn_readfirstlane(s); unsigned char* ws = F.ws;
    LAS int* tst = (LAS int*)(F.lds + MISC_OFF + 64); LAS int* texp = (LAS int*)(F.lds + MISC_OFF + 128);
    const int* rtok = (const int*)(ws + MS_RTOK) + s * MAXROWS;
    const int ntl = moe_tables(F, s, tst, texp);
    pg8::MoeUpOrder S; S.init(ntl, 2 * FFE / 256, F.G, (int)blockIdx.x); S.texp = texp;
    S.ebase = F.lds + ARGS_OFF + 8 * 40;
    if (F.tid < 8) { const int e = F.tid; *(LAS unsigned long long*)(F.lds + ARGS_OFF + 8 * 40 + 8 * e) = (unsigned long long)wm13_base(e, ws, F.out); }
    LAS int* gtab = (LAS int*)(F.lds + TAB_OFF);
    { pg8::Unit u; for (int i = 0; i < 16 && S.next(i, u); ++i) { if (F.tid < 256) gtab[i * 256 + F.tid] = rtok[u.pm * 256 + F.tid]; } }
    __syncthreads();
    pg8::Gemm g{(const bf16*)(ws + WS_H), (const bf16*)(ws + WS_WM13), D, D, D};
    pg8::EpiSwiglu E{(bf16*)(ws + WS_ACT), FFE};
    pg8::gemm_phase<pg8::EpiSwiglu, pg8::MoeUpOrder, true>(F.lds, g, S, E, gtab); }
__device__ __forceinline__ int moe_tail_ks(int ntail) { return ntail == 0 ? 1 : (ntail <= 14 ? 14 : (ntail <= 28 ? 7 : (ntail <= 98 ? 2 : 1))); }
constexpr size_t WS_PART = 384 * MiB;
PHASE_FN ph_moe_down(int s) { Frame F; frame_init(F); s = __builtin_amdgcn_readfirstlane(s); unsigned char* ws = F.ws;
    LAS int* tst = (LAS int*)(F.lds + MISC_OFF + 64); LAS int* texp = (LAS int*)(F.lds + MISC_OFF + 128);
    const int* rtok = (const int*)(ws + MS_RTOK) + s * MAXROWS; const float* rgate = (const float*)(ws + MS_RGATE) + s * MAXROWS;
    const int ntl = moe_tables(F, s, tst, texp);
    pg8::MoeOrder S; S.init(ntl, 4, F.G, (int)blockIdx.x); S.texp = texp;
    const int nfull = (S.nwg / F.G) * F.G, ntail = S.nwg - nfull, KS = moe_tail_ks(ntail);
    if (KS > 1) S.lim = nfull;
    { pg8::Gemm g{(const bf16*)(ws + WS_ACT), (const bf16*)(ws + WS_WM2), FFE, FFE, FFE};
      pg8::EpiMoeDown E{XB, s == 0 ? XB : (bf16*)(ws + WS_H), rtok, rgate};
      pg8::gemm_phase<pg8::EpiMoeDown, pg8::MoeOrder>(F.lds, g, S, E); }
    if (KS > 1) { pg8::MoeTailOrder St; St.init(ntl, 4, F.G, (int)blockIdx.x); St.texp = texp; St.first = nfull; St.KS = KS; St.Ksub = FFE / KS; St.nsub = ntail * KS;
      pg8::Gemm g{(const bf16*)(ws + WS_ACT), (const bf16*)(ws + WS_WM2), FFE / KS, FFE, FFE};
      pg8::EpiPartial E{(float*)(ws + WS_PART), nfull, KS};
      pg8::gemm_phase<pg8::EpiPartial, pg8::MoeTailOrder>(F.lds, g, St, E); } }
PHASE_FN ph_moe_tail_reduce(int s) { Frame F; frame_init(F); s = __builtin_amdgcn_readfirstlane(s); unsigned char* ws = F.ws;
    LAS int* tst = (LAS int*)(F.lds + MISC_OFF + 64); LAS int* texp = (LAS int*)(F.lds + MISC_OFF + 128);
    const int* rtok = (const int*)(ws + MS_RTOK) + s * MAXROWS; const float* rgate = (const float*)(ws + MS_RGATE) + s * MAXROWS;
    const int ntl = moe_tables(F, s, tst, texp);
    pg8::MoeOrder S; S.init(ntl, 4, F.G, (int)blockIdx.x); S.texp = texp;
    const int nfull = (S.nwg / F.G) * F.G, ntail = S.nwg - nfull, KS = moe_tail_ks(ntail);
    if (KS <= 1) return;
    const float* part = (const float*)(ws + WS_PART);
    const int gw = F.vcu * NWAVES + F.wave, NGW = F.G * NWAVES;
    for (int it = gw; it < ntail * 256; it += NGW) { const int tu = it >> 8, r = it & 255; pg8::Unit u; S.decode(nfull + tu, u);
        const int row = u.pm * 256 + r; const int tok = rtok[row]; if (tok < 0) continue; const float gt = rgate[row];
        f32x4 a = *(const f32x4*)(part + ((size_t)(tu * KS) * 256 + r) * 256 + 4 * F.lane);
        for (int k = 1; k < KS; ++k) a += *(const f32x4*)(part + ((size_t)(tu * KS + k) * 256 + r) * 256 + 4 * F.lane);
        const size_t xo = (size_t)tok * 1024 + u.pn * 256 + 4 * F.lane; const v2u w = *(const v2u*)(XB + xo);
        f32x4 xv; xv.x = __builtin_bit_cast(float, w.x << 16); xv.y = __builtin_bit_cast(float, w.x & 0xffff0000u); xv.z = __builtin_bit_cast(float, w.y << 16); xv.w = __builtin_bit_cast(float, w.y & 0xffff0000u);
        xv += a * gt; v2u ow; ow.x = pk2(xv.x, xv.y); ow.y = pk2(xv.z, xv.w);
        *(v2u*)((s == 0 ? XB : (bf16*)(ws + WS_H)) + xo) = ow; } }
PHASE_FN ph_final() { Frame F; frame_init(F); final_norm_rows(F, (const bf16*)(F.ws + WS_H), F.out, AIN(I_FN)); }

__global__ void __launch_bounds__(NWAVES * 64, 2) mega_fwd(Args args) {
    extern __shared__ __attribute__((aligned(16))) unsigned char lds[];
    LAS unsigned char* L = (LAS unsigned char*)lds;
    for (int u = threadIdx.x; u < 256; u += NWAVES * 64) ((LAS unsigned*)(L + MISC_OFF))[u] = 0u;
    if (threadIdx.x == 0) { LAS unsigned long long* ap = (LAS unsigned long long*)(L + ARGS_OFF);
#pragma unroll
        for (int i = 0; i < 31; ++i) ap[i] = (unsigned long long)args.in[i];
        ap[31] = (unsigned long long)args.out; ap[32] = (unsigned long long)args.ws; }
    __syncthreads();
#if MK_ONE_LAUNCH
    (void)xcd_barrier_post((unsigned*)(args.ws + WS_CTL) + CW_BAR, (volatile LAS unsigned*)(L + MISC_OFF) + 8);
#define GRID_BAR() xcd_barrier()
#else
#define GRID_BAR() do { } while (0)
#endif
    const int lo = args.ph_lo, hi = args.ph_hi;
#define IN(k) (lo <= (k) && (k) < hi)
#define SEAM(k) do { if (IN(k) && IN((k) + 1)) GRID_BAR(); } while (0)
    if (SITE(0) && IN(PH_PRO)) RUN(0, ph_prologue());
    for (int Ly = 0; Ly < DEPTH; ++Ly) {
        const int pb = 1 + PH_L * Ly;
        if (SITE(1) && IN(pb + 0)) RUN(1, ph_norm1(Ly)); SEAM(pb + 0);
        if (SITE(2) && IN(pb + 1)) RUN(2, ph_gemm1(Ly)); SEAM(pb + 1);
        if (SITE(3) && IN(pb + 2)) RUN(3, ph_prepA(Ly)); SEAM(pb + 2);
        if (IN(pb + 3)) RUN(4, { if (SITE(4)) ph_lora(Ly); if (SITE(18)) ph_mla(Ly); }); SEAM(pb + 3);
        if (SITE(5) && IN(pb + 4)) RUN(5, ph_attn()); SEAM(pb + 4);
        if (SITE(6) && IN(pb + 5)) RUN(6, ph_scanpre(Ly)); SEAM(pb + 5);
        if (SITE(7) && IN(pb + 6)) RUN(7, ph_scanseq(Ly, r_ > 0 ? SS_MODE : 0)); if (IN(pb + 6) && IN(pb + 8)) GRID_BAR();
        if (SITE(9) && IN(pb + 8)) ph_gemm2(Ly); SEAM(pb + 8);
        if (Ly == 0) {
            if (SITE(10) && IN(pb + 9)) ph_norm2d(); SEAM(pb + 9);
            if (SITE(11) && IN(pb + 10)) RUN(11, ph_up_dense()); SEAM(pb + 10);
            if (SITE(12) && IN(pb + 11)) ph_down_dense(); SEAM(pb + 11);
        } else {
            if (IN(pb + 9)) { if (SITE(13)) ph_norm_router(); } SEAM(pb + 9);
        }
    }
    if (SITE(14) && IN(PH_SCAT)) ph_scatter(); SEAM(PH_SCAT);
    for (int s = 0; s < 2; ++s) {
        if (SITE(15) && IN(PH_UP0 + 2 * s)) { if (s == 1) ph_moe_tail_reduce(0);
            RUN(15, ph_moe_up(s)); } SEAM(PH_UP0 + 2 * s);
        if (SITE(16) && IN(PH_DN0 + 2 * s)) { ph_moe_down(s); if (s == 1) { GRID_BAR(); ph_moe_tail_reduce(1); } } SEAM(PH_DN0 + 2 * s);
    }
    if (SITE(17) && IN(PH_FIN)) ph_final();
#undef IN
#undef SEAM
}

extern "C" void kernel_launch(void* const* d_in, const int* in_sizes, int n_in, void* d_out, int out_size, void* d_ws, size_t ws_size, hipStream_t stream) {
    static int grid = 0;
    if (grid == 0) {
        if (n_in != 31 || in_sizes[0] != M * D || out_size != M * D || ws_size < WS_END) { fprintf(stderr, "kernel_launch: unexpected shapes / workspace (%d inputs, ws %zu, need %zu)\n", n_in, ws_size, (size_t)WS_END); grid = -1; return; }
        int dev = 0, cus = 0, per_cu = 0;
        if (hipGetDevice(&dev) != hipSuccess || hipDeviceGetAttribute(&cus, hipDeviceAttributeMultiprocessorCount, dev) != hipSuccess) { grid = -1; return; }
        if (hipFuncSetAttribute((const void*)mega_fwd, hipFuncAttributeMaxDynamicSharedMemorySize, LDS_BYTES) != hipSuccess) { fprintf(stderr, "kernel_launch: hipFuncSetAttribute failed\n"); grid = -1; return; }
        if (hipOccupancyMaxActiveBlocksPerMultiprocessor(&per_cu, (const void*)mega_fwd, NWAVES * 64, LDS_BYTES) != hipSuccess || per_cu < 1) fprintf(stderr, "kernel_launch: occupancy query reports %d\n", per_cu);
        (void)hipGetLastError();
        grid = cus;
        if (grid != 256) { fprintf(stderr, "kernel_launch: built for 256 CUs, found %d\n", cus); grid = -1; return; }
    }
    if (grid < 0) return;
    (void)hipMemsetAsync((char*)d_ws + WS_CTL, 0, CTL_ZERO_BYTES, stream);
    Args a{};
    for (int i = 0; i < 31; ++i) a.in[i] = (const float*)d_in[i];
    a.out = (float*)d_out; a.ws = (unsigned char*)d_ws;
#if MK_ONE_LAUNCH
    a.ph_lo = 0; a.ph_hi = N_PHASES;
    hipLaunchKernelGGL(mega_fwd, dim3(grid), dim3(NWAVES * 64), LDS_BYTES, stream, a);
#else
    for (int p = 0; p < N_PHASES; ++p) { a.ph_lo = p; a.ph_hi = p + 1; hipLaunchKernelGGL(mega_fwd, dim3(grid), dim3(NWAVES * 64), LDS_BYTES, stream, a); }
#endif
}
```

```cpp
#include <hip/hip_runtime.h>
#include <cstdio>
#include <cstdint>

#ifndef SITE_MASK
#define SITE_MASK 0xffffffffu
#endif
#define SITE(n) ((SITE_MASK >> (n)) & 1u)
#ifndef REP_MASK
#define REP_MASK 0u
#endif
#ifndef REP_N
#define REP_N 3
#endif
#ifndef SS_MODE
#define SS_MODE 0
#endif
#define REPS(n) (((REP_MASK >> (n)) & 1u) ? REP_N : 1)
#define RUN(n, call) do { for (int r_ = 0; r_ < REPS(n); ++r_) { if (r_) GRID_BAR(); call; } } while (0)
#ifndef MK_ONE_LAUNCH
#define MK_ONE_LAUNCH 1
#endif

#define GAS __attribute__((address_space(1)))
#define LAS __attribute__((address_space(3)))
typedef unsigned short bf16;
typedef unsigned v4u __attribute__((ext_vector_type(4)));
typedef unsigned v2u __attribute__((ext_vector_type(2)));
typedef float f32x2 __attribute__((ext_vector_type(2)));
typedef float f32x4 __attribute__((ext_vector_type(4)));
typedef float f32x16 __attribute__((ext_vector_type(16)));
typedef short bf16x8 __attribute__((ext_vector_type(8)));
typedef short s16x4 __attribute__((ext_vector_type(4)));

constexpr int D = 1024, NB = 16, T = 2048, M = NB * T, DEPTH = 2;
constexpr int NIN = 3232, NINP = 3328;
constexpr int FF = 2816, FFE = 3584, NEXP = 8;
constexpr int MAXT = 135;
constexpr int MAXROWS = MAXT * 256;

constexpr size_t MiB = 1u << 20;
constexpr size_t WS_CTL = 0, CTL_ZERO_BYTES = 256 * 1024;
constexpr size_t WS_WIN = 1 * MiB;
constexpr size_t WS_WOUT = 14 * MiB;
constexpr size_t WS_WLORA = 18 * MiB;
constexpr size_t WS_WMLA = 19 * MiB;
constexpr size_t WS_W13D = 21 * MiB;
constexpr size_t WS_W2D = 32 * MiB;
constexpr size_t WS_ROPE = 38 * MiB;
constexpr size_t WS_MISC = 50 * MiB;
constexpr size_t WS_H = 52 * MiB;
constexpr size_t WS_CR = 116 * MiB;
constexpr size_t WS_CD = 180 * MiB;
constexpr size_t WS_CM = 228 * MiB;
constexpr size_t WS_CH = 260 * MiB;
constexpr size_t WS_AL = 324 * MiB;
constexpr size_t WS_LO = 340 * MiB;
constexpr size_t WS_QM = 388 * MiB;
constexpr size_t WS_KVM = 412 * MiB;
constexpr size_t SP_RP = 180 * MiB;
constexpr size_t SP_KQT = 212 * MiB;
constexpr size_t SP_E = 244 * MiB;
constexpr size_t SP_PC = 252 * MiB;
constexpr size_t SP_BS = 256 * MiB;
constexpr size_t SP_VT = 388 * MiB;
constexpr size_t SP_K2 = 420 * MiB;
constexpr size_t SP_TB = 436 * MiB;
constexpr size_t SP_FM = 440 * MiB;
constexpr size_t SP_AQT = 324 * MiB;
constexpr size_t WS_ACT = 116 * MiB;
constexpr size_t WS_WM13 = 356 * MiB;
constexpr size_t WS_WM2 = 468 * MiB;
constexpr size_t WS_END = 524 * MiB;
static_assert(WS_ACT + (size_t)MAXROWS * FFE * 2 <= WS_WM13, "act vs wm13");
constexpr size_t MS_RS = WS_MISC;
constexpr size_t MS_TOPE = WS_MISC + 256 * 1024;
constexpr size_t MS_GATE = WS_MISC + 512 * 1024;
constexpr size_t MS_RANK = WS_MISC + 768 * 1024;
constexpr size_t MS_RTOK = WS_MISC + 1024 * 1024;
constexpr size_t MS_RGATE = WS_MISC + 1024 * 1024 + 320 * 1024;
static_assert((size_t)2 * MAXROWS * 4 <= 320 * 1024 && MS_RGATE + 320 * 1024 <= WS_H, "misc map");
constexpr int CW_CNT = 64;
constexpr int CW_BAR = 4096;

constexpr int RING_BYTES = 131072;
constexpr int TAB_OFF = RING_BYTES, TAB_BYTES = 16 * 1024;
constexpr int MISC_OFF = TAB_OFF + TAB_BYTES;
constexpr int ARGS_OFF = MISC_OFF + 1024;
constexpr int LDS_BYTES = ARGS_OFF + 512;
constexpr int NWAVES = 8;

#define LDS_WAIT() asm volatile("s_waitcnt lgkmcnt(0)" ::: "memory")
#define VM_WAIT() asm volatile("s_waitcnt vmcnt(0)" ::: "memory")
typedef __bf16 bf16x2_t __attribute__((ext_vector_type(2)));
__device__ __forceinline__ unsigned cvt_pk_bf16(float lo, float hi) { const f32x2 v = {lo, hi}; const bf16x2_t b = __builtin_convertvector(v, bf16x2_t); return __builtin_bit_cast(unsigned, b); }
__device__ __forceinline__ unsigned f2bf(float f) { return cvt_pk_bf16(f, 0.f) & 0xffffu; }
__device__ __forceinline__ unsigned pk2(float lo, float hi) { return cvt_pk_bf16(lo, hi); }
__device__ __forceinline__ float bf2f(unsigned b) { return __builtin_bit_cast(float, b << 16); }
__device__ __forceinline__ float bflo(unsigned w) { return __builtin_bit_cast(float, w << 16); }
__device__ __forceinline__ float bfhi(unsigned w) { return __builtin_bit_cast(float, w & 0xffff0000u); }
__device__ __forceinline__ unsigned cvt_pk_bf16_asm(float lo, float hi) { unsigned r; asm volatile("v_cvt_pk_bf16_f32 %0, %1, %2" : "=v"(r) : "v"(lo), "v"(hi)); return r; }
__device__ __forceinline__ float fexp(float x) { return __builtin_amdgcn_exp2f(x * 1.4426950408889634f); }
__device__ __forceinline__ float frcp(float x) { return __builtin_amdgcn_rcpf(x); }
__device__ __forceinline__ float sigmoidf_(float x) { return frcp(1.0f + fexp(-x)); }
__device__ __forceinline__ float siluf_(float x) { return x * sigmoidf_(x); }
__device__ __forceinline__ float tanhf_(float x) { return 1.0f - 2.0f * frcp(1.0f + fexp(2.0f * x)); }
__device__ __forceinline__ float wave_sum_dpp(float v);
__device__ __forceinline__ float wave_sum(float v) { return wave_sum_dpp(v); }
template <int CTRL> __device__ __forceinline__ float dpp_f(float v) { return __builtin_bit_cast(float, __builtin_amdgcn_update_dpp(0, __builtin_bit_cast(int, v), CTRL, 0xf, 0xf, false)); }
template <int CTRL, int RMASK> __device__ __forceinline__ float dpp_rm(float v) { return __builtin_bit_cast(float, __builtin_amdgcn_update_dpp(0, __builtin_bit_cast(int, v), CTRL, RMASK, 0xf, false)); }
__device__ __forceinline__ float row16_sum(float v);
__device__ __forceinline__ float wave_sum_dpp(float v) {
    v = row16_sum(v);
    v += dpp_rm<0x142, 0xa>(v);
    v += dpp_rm<0x143, 0xc>(v);
    return __builtin_bit_cast(float, __builtin_amdgcn_readlane(__builtin_bit_cast(int, v), 63));
}
__device__ __forceinline__ float row16_sum(float v) {
    v += dpp_f<0x128>(v);
    v += dpp_f<0x124>(v);
    v += dpp_f<0x122>(v);
    v += dpp_f<0x121>(v);
    return v;
}

#define BAR_WS_ARG (ARGS_OFF + 8 * 32)
#define WS_CTL_BAR_BYTES (WS_CTL + (size_t)CW_BAR * 4)
#define BAR_ST_OFF (MISC_OFF + 32)
__device__ __forceinline__ unsigned long long lds_arg_u64(int byte_off) { const v2u w = *(const LAS v2u*)(unsigned)byte_off;
    const unsigned lo = __builtin_amdgcn_readfirstlane(w.x), hi = __builtin_amdgcn_readfirstlane(w.y); return ((unsigned long long)hi << 32) | lo; }
#define XB_TMO      128
#define XB_XCNT(j)  (256  + 64 * (j))
#define XB_XSUB(j)  (1280 + 64 * (j))
#define XB_XGEN(j)  (2304 + 64 * (j))
#define XB_TOP      3328
#define XB_TOPGEN   3392
#define XCD_BAR_WORDS 3456
#define XB_SPIN_CAP (1u << 18)
__device__ __forceinline__ unsigned xb_ld(unsigned* p)              { return __hip_atomic_load(p, __ATOMIC_RELAXED, __HIP_MEMORY_SCOPE_AGENT); }
__device__ __forceinline__ unsigned xb_add(unsigned* p, unsigned v) { return __hip_atomic_fetch_add(p, v, __ATOMIC_RELAXED, __HIP_MEMORY_SCOPE_AGENT); }
__device__ __forceinline__ unsigned xb_xcc_id() { return (unsigned)__builtin_amdgcn_s_getreg((3 << 11) | 20) & 0xFu; }
#define XB_SPIN(cond, bar) do { unsigned _sp = 0; while (cond) { __builtin_amdgcn_s_sleep(1); \
    if ((++_sp & 255u) == 0u) { if (xb_ld(&(bar)[XB_TMO])) break; if (_sp > XB_SPIN_CAP) { atomicAdd(&(bar)[XB_TMO], 1u); break; } } } } while (0)
struct XcdBarrier { unsigned* bar; unsigned x; volatile LAS unsigned* st; };
__device__ __forceinline__ XcdBarrier xcd_barrier_post(unsigned* bar, volatile LAS unsigned* st) {
    XcdBarrier b; b.bar = bar; b.x = xb_xcc_id(); b.st = st;
    if (threadIdx.x == 0) (void)xb_add(&bar[XB_XCNT(b.x)], 1u);
    return b;
}
__device__ __forceinline__ void xcd_barrier_complete(unsigned* bar, unsigned x, unsigned& nloc, unsigned& nx) {
    const unsigned G = gridDim.x * gridDim.y * gridDim.z;
    unsigned sum, cnt, mine, sp = 0u;
    for (;;) {
        sum = 0u; cnt = 0u; mine = 0u;
#pragma unroll
        for (unsigned j = 0; j < 16; ++j) { const unsigned c = xb_ld(&bar[XB_XCNT(j)]); sum += c; cnt += (c > 0u) ? 1u : 0u; mine = (j == x) ? c : mine; }
        if (sum == G) break;
        __builtin_amdgcn_s_sleep(1);
        if ((++sp & 255u) == 0u) { if (xb_ld(&bar[XB_TMO])) break; if (sp > XB_SPIN_CAP) { atomicAdd(&bar[XB_TMO], 1u); break; } }
    }
    nloc = mine > 0u ? mine : 1u; nx = cnt > 0u ? cnt : 1u;
}
__device__ __attribute__((noinline)) void xcd_barrier() {
    XcdBarrier b; b.bar = (unsigned*)(GAS unsigned*)(lds_arg_u64(BAR_WS_ARG) + WS_CTL_BAR_BYTES); b.x = xb_xcc_id(); b.st = (volatile LAS unsigned*)(unsigned)(BAR_ST_OFF);
    asm volatile("s_waitcnt vmcnt(0)" ::: "memory");
    __syncthreads();
    if (threadIdx.x == 0) {
        unsigned* bar = b.bar;
        __builtin_amdgcn_s_waitcnt(0);
        unsigned nloc = b.st[0], nx = b.st[1];
        if (nloc == 0u) { xcd_barrier_complete(bar, b.x, nloc, nx); b.st[0] = nloc; b.st[1] = nx; }
        const unsigned old = xb_add(&bar[XB_XSUB(b.x)], 1u);
        const unsigned gen = old / nloc;
        if (old + 1u == (gen + 1u) * nloc) {
            __builtin_amdgcn_fence(__ATOMIC_RELEASE, "agent");
            asm volatile("s_waitcnt vmcnt(0)" ::: "memory");
            const unsigned og = xb_add(&bar[XB_TOP], 1u);
            const unsigned tg = og / nx;
            if (og + 1u == (tg + 1u) * nx) xb_add(&bar[XB_TOPGEN], 1u);
            else XB_SPIN(xb_ld(&bar[XB_TOPGEN]) == tg, bar);
            __builtin_amdgcn_fence(__ATOMIC_ACQUIRE, "agent");
            xb_add(&bar[XB_XGEN(b.x)], 1u);
            asm volatile("s_waitcnt vmcnt(0)" ::: "memory");
        } else {
            XB_SPIN(xb_ld(&bar[XB_XGEN(b.x)]) == gen, bar);
            __builtin_amdgcn_fence(__ATOMIC_ACQUIRE, "agent");
            asm volatile("s_waitcnt vmcnt(0)" ::: "memory");
        }
    }
    __syncthreads();
}

namespace pg8 {
constexpr int BM = 256, BK = 64, HALF = 128, HTB = HALF * BK * 2, STAGE_BYTES = 8 * HTB, NXCD = 8, WGM = 4;
__host__ __device__ __forceinline__ int lds_byte(int r, int c) { const int st = (r >> 4) * 2 + (c >> 5), rr = r & 15, cc = c & 31, ob = rr * 64 + cc * 2; return st * 1024 + (ob ^ (((ob >> 9) & 1) << 5)); }
__host__ __device__ __forceinline__ void stage_rc(int b, int& R, int& C) { const int st = b / 1024, sb = b % 1024, swz = sb ^ (((sb >> 9) & 1) << 5); R = (st >> 1) * 16 + swz / 64; C = (st & 1) * 32 + (swz % 64) / 2; }
__host__ __device__ __forceinline__ int perm32(int rho) { const int n = rho >> 4, i = rho & 15; return 8 * (i >> 2) + 4 * n + (i & 3); }

struct Unit { int pm, pn, ks, su; };
struct Gemm { const bf16* A; const bf16* Bt; int K; int lda; int ldb; };

struct StaticOrder {
    int nM, nN, nwg, G, c, lim;
    __device__ void init(int nM_, int nN_, int G_, int c_) { nM = nM_; nN = nN_; nwg = nM * nN; G = G_; c = c_; lim = nwg; }
    __device__ void decode(int L, Unit& u) const {
        int wgid = L; { const int q = nwg / NXCD, r = nwg % NXCD, xcd = wgid % NXCD, off = wgid / NXCD; wgid = (xcd < r ? xcd * (q + 1) : r * (q + 1) + (xcd - r) * q) + off; }
        const int nig = WGM * nN, gid = wgid / nig, fm = gid * WGM, gsz = (nM - fm) < WGM ? (nM - fm) : WGM;
        u.pm = fm + ((wgid % nig) % gsz); u.pn = (wgid % nig) / gsz; u.ks = 0; u.su = L;
    }
    __device__ bool next(int i, Unit& u) const { const long L = (long)i * G + c; if (L >= lim) return false; decode((int)L, u); return true; }
    __device__ __forceinline__ int a_tile(const Unit& u) const { return u.pm; }
    __device__ __forceinline__ int b_tile(const Unit& u) const { return u.pn; }
    __device__ __forceinline__ const char* b_ptr(const Unit& u, const void* Bt, size_t tstepB) const { return (const char*)Bt + (size_t)u.pn * tstepB; }
    __device__ __forceinline__ int k_off(const Unit&) const { return 0; }
};
struct MoeOrder : StaticOrder {
    const LAS int* texp;
    __device__ __forceinline__ int b_tile(const Unit& u) const { return texp[u.pm] * nN + u.pn; }
    __device__ __forceinline__ const char* b_ptr(const Unit& u, const void* Bt, size_t tstepB) const { return (const char*)Bt + (size_t)(texp[u.pm] * nN + u.pn) * tstepB; }
};
struct MoeUpOrder : MoeOrder {
    const LAS unsigned char* ebase;
    __device__ __forceinline__ const char* b_ptr(const Unit& u, const void*, size_t tstepB) const {
        const v2u w = *(const LAS v2u*)(ebase + 8 * texp[u.pm]); const unsigned lo = __builtin_amdgcn_readfirstlane(w.x), hi = __builtin_amdgcn_readfirstlane(w.y);
        return (const char*)(const GAS char*)(((unsigned long long)hi << 32) | lo) + (size_t)u.pn * tstepB; }
};
struct MoeTailOrder : MoeOrder {
    int first, nsub, KS, Ksub;
    __device__ bool next(int i, Unit& u) const { const long j = (long)i * G + c; if (j >= nsub) return false; decode(first + (int)(j / KS), u); u.ks = (int)(j % KS); return true; }
    __device__ __forceinline__ int k_off(const Unit& u) const { return u.ks * Ksub; }
};

template <class Epi, class Sched, bool GATHER = false>
__device__ __forceinline__ void gemm_phase(LAS unsigned char* lds, const Gemm g, const Sched& S, const Epi& E, const LAS int* gtab = nullptr) {
    int tid_ = threadIdx.x; asm volatile("" : "+v"(tid_));
    const int tid = tid_, wid = __builtin_amdgcn_readfirstlane(tid >> 6), lane = tid & 63, wr = wid >> 2, wc = wid & 3, fr = lane & 15, fq = lane >> 4;
    const int K = g.K, nt = K / BK, lda = g.lda, ldb = g.ldb;
    unsigned voffB[2]; unsigned vA0[2], vA1[2];
#pragma unroll
    for (int i = 0; i < 2; ++i) { int R, C; stage_rc(tid * 16 + i * 8192, R, C); const int Rb = Epi::PERM ? ((R & ~31) + perm32(R & 31)) : R;
        voffB[i] = (unsigned)(Rb * ldb + C) * 2u;
        vA0[i] = (unsigned)(R * lda + C) * 2u; vA1[i] = (unsigned)((R + HALF) * lda + C) * 2u; }
    const size_t kstep = (size_t)(BK * 2);
    const size_t hstep = (size_t)HALF * ldb * 2;
    const size_t tstepB = 2 * hstep;
    const size_t tstepA = (size_t)BM * lda * 2;
    const unsigned ldsw = (unsigned)wid * 1024u;
    const int aoff = lds_byte(wr * 64 + fr, fq * 8), boff = lds_byte(wc * 32 + fr, fq * 8);
#define PG8_SA(b, h) (((b) * 2 + (h)) * HTB)
#define PG8_SB(b, h) ((4 + (b) * 2 + (h)) * HTB)
#define PG8_STAGE(bufoff, gbase, voff) do { _Pragma("unroll") for (int _i = 0; _i < 2; ++_i) \
        __builtin_amdgcn_global_load_lds((const unsigned*)((const char*)(gbase) + (voff)[_i]), (LAS unsigned*)(lds + (bufoff) + ldsw + _i * 8192), 16, 0, 0); } while (0)
#define PG8_LDA(dst, b, h) do { _Pragma("unroll") for (int m = 0; m < 4; ++m) _Pragma("unroll") for (int k = 0; k < 2; ++k) dst[m][k] = *(const LAS bf16x8*)(lds + PG8_SA(b, h) + aoff + m * 2048 + k * 1024); } while (0)
#define PG8_LDB(dst, b, h) do { _Pragma("unroll") for (int n = 0; n < 2; ++n) _Pragma("unroll") for (int k = 0; k < 2; ++k) dst[n][k] = *(const LAS bf16x8*)(lds + PG8_SB(b, h) + boff + n * 2048 + k * 1024); } while (0)
#define PG8_MMA(ai, bj, At, Bt) do { __builtin_amdgcn_s_setprio(1); _Pragma("unroll") for (int m = 0; m < 4; ++m) _Pragma("unroll") for (int n = 0; n < 2; ++n) _Pragma("unroll") for (int k = 0; k < 2; ++k) \
        acc[ai][bj][m][n] = __builtin_amdgcn_mfma_f32_16x16x32_bf16(Bt[n][k], At[m][k], acc[ai][bj][m][n], 0, 0, 0); __builtin_amdgcn_s_setprio(0); } while (0)
#define PG8_WAIT_V(n) asm volatile("s_waitcnt vmcnt(" #n ")" ::: "memory")
#define PG8_WAIT_L(n) asm volatile("s_waitcnt lgkmcnt(" #n ")" ::: "memory")
#define PG8_BAR __builtin_amdgcn_s_barrier()
#define PG8_SCHED __builtin_amdgcn_sched_barrier(0)
    Unit cur, nxt; int ui = 0;
    if (!S.next(0, cur)) return;
    f32x4 acc[2][2][4][2];
    float zf = 0.f; asm volatile("" : "+v"(zf));
#pragma unroll
    for (int a = 0; a < 2; ++a)
#pragma unroll
        for (int b = 0; b < 2; ++b)
#pragma unroll
            for (int m = 0; m < 4; ++m)
#pragma unroll
                for (int n = 0; n < 2; ++n) acc[a][b][m][n] = (f32x4){zf, zf, zf, zf};
    bf16x8 At[4][2], B0[2][2], B1[2][2];
    const char* cA; const char* cB = S.b_ptr(cur, g.Bt, tstepB) + (size_t)S.k_off(cur) * 2;
    if constexpr (GATHER) {
        cA = (const char*)g.A;
        asm volatile("" ::: "memory");
#pragma unroll
        for (int i = 0; i < 2; ++i) { int R, C; stage_rc(tid * 16 + i * 8192, R, C); int t0 = gtab[R], t1 = gtab[HALF + R]; t0 = t0 < 0 ? 0 : t0; t1 = t1 < 0 ? 0 : t1;
            vA0[i] = (unsigned)(t0 * lda + C) * 2u; vA1[i] = (unsigned)(t1 * lda + C) * 2u; }
        asm volatile("s_waitcnt lgkmcnt(0)" ::: "memory");
    } else cA = (const char*)g.A + (size_t)S.a_tile(cur) * tstepA + (size_t)S.k_off(cur) * 2;
    PG8_STAGE(PG8_SB(0, 0), cB, voffB); PG8_STAGE(PG8_SA(0, 0), cA, vA0); PG8_STAGE(PG8_SB(0, 1), cB + hstep, voffB); PG8_STAGE(PG8_SA(0, 1), cA, vA1);
    if (wr == 1) PG8_BAR;
    PG8_WAIT_V(4); PG8_BAR;
    PG8_STAGE(PG8_SB(1, 0), cB + kstep, voffB); PG8_STAGE(PG8_SA(1, 0), cA + kstep, vA0); PG8_STAGE(PG8_SB(1, 1), cB + hstep + kstep, voffB);
    PG8_WAIT_V(6); PG8_BAR;
    for (;;) {
        const bool has_next = S.next(ui + 1, nxt);
        const char* nA; const char* nB = has_next ? S.b_ptr(nxt, g.Bt, tstepB) + (size_t)S.k_off(nxt) * 2 : cB;
        if constexpr (GATHER) nA = cA; else nA = has_next ? (const char*)g.A + (size_t)S.a_tile(nxt) * tstepA + (size_t)S.k_off(nxt) * 2 : cA;
#pragma unroll 1
        for (int t = 0; t < nt; t += 2) {
            const bool last = (t == nt - 2);
            const char* a1 = cA + (size_t)(t + 1) * kstep;
            const char* a2 = last ? nA : cA + (size_t)(t + 2) * kstep; const char* b2 = last ? nB : cB + (size_t)(t + 2) * kstep;
            const char* a3 = a2 + kstep; const char* b3 = b2 + kstep;
            unsigned t1v[2] = {vA1[0], vA1[1]};
            if constexpr (GATHER) {
                if (last && has_next) {
                    asm volatile("" ::: "memory");
                    const LAS int* tb = gtab + (ui + 1) * 256;
#pragma unroll
                    for (int i = 0; i < 2; ++i) { int R, C; stage_rc(tid * 16 + i * 8192, R, C); int t0 = tb[R], t1 = tb[HALF + R]; t0 = t0 < 0 ? 0 : t0; t1 = t1 < 0 ? 0 : t1;
                        vA0[i] = (unsigned)(t0 * lda + C) * 2u; t1v[i] = (unsigned)(t1 * lda + C) * 2u; }
                    asm volatile("s_waitcnt lgkmcnt(0)" ::: "memory");
                }
            }
            PG8_LDB(B0, 0, 0); PG8_SCHED; PG8_LDA(At, 0, 0); PG8_STAGE(PG8_SA(1, 1), a1, vA1);
            if constexpr (GATHER) { vA1[0] = t1v[0]; vA1[1] = t1v[1]; }
            PG8_WAIT_L(8); PG8_BAR; PG8_WAIT_L(0); PG8_MMA(0, 0, At, B0); PG8_BAR; PG8_SCHED;
            PG8_LDB(B1, 0, 1); PG8_STAGE(PG8_SB(0, 0), b2, voffB);
            PG8_BAR; PG8_WAIT_L(0); PG8_MMA(0, 1, At, B1); PG8_BAR;
            PG8_LDA(At, 0, 1); PG8_STAGE(PG8_SA(0, 0), a2, vA0);
            PG8_BAR; PG8_WAIT_L(0); PG8_MMA(1, 0, At, B0); PG8_BAR; PG8_SCHED;
            PG8_STAGE(PG8_SB(0, 1), b2 + hstep, voffB);
            PG8_WAIT_V(6); PG8_BAR; PG8_MMA(1, 1, At, B1); PG8_BAR;
            PG8_LDB(B0, 1, 0); PG8_SCHED; PG8_LDA(At, 1, 0); PG8_STAGE(PG8_SA(0, 1), a2, vA1);
            PG8_WAIT_L(8); PG8_BAR; PG8_WAIT_L(0); PG8_MMA(0, 0, At, B0); PG8_BAR; PG8_SCHED;
            PG8_LDB(B1, 1, 1); PG8_STAGE(PG8_SB(1, 0), b3, voffB);
            PG8_BAR; PG8_WAIT_L(0); PG8_MMA(0, 1, At, B1); PG8_BAR;
            PG8_LDA(At, 1, 1); PG8_STAGE(PG8_SA(1, 0), a3, vA0);
            PG8_BAR; PG8_WAIT_L(0); PG8_MMA(1, 0, At, B0); PG8_BAR; PG8_SCHED;
            PG8_STAGE(PG8_SB(1, 1), b3 + hstep, voffB);
            PG8_WAIT_V(6); PG8_BAR; PG8_MMA(1, 1, At, B1); PG8_BAR;
        }
        E(acc, cur, wr, wc, fr, fq);
        if (!has_next) break;
#pragma unroll
        for (int a = 0; a < 2; ++a)
#pragma unroll
            for (int b = 0; b < 2; ++b)
#pragma unroll
                for (int m = 0; m < 4; ++m)
#pragma unroll
                    for (int n = 0; n < 2; ++n) acc[a][b][m][n] = (f32x4){zf, zf, zf, zf};
        cur = nxt; cA = nA; cB = nB; ++ui;
    }
    PG8_WAIT_V(0);
    if (wr == 0) PG8_BAR;
    PG8_BAR;
#undef PG8_SA
#undef PG8_SB
#undef PG8_STAGE
#undef PG8_LDA
#undef PG8_LDB
#undef PG8_MMA
#undef PG8_WAIT_V
#undef PG8_WAIT_L
#undef PG8_BAR
#undef PG8_SCHED
}

typedef const f32x4 (&AccRef)[2][2][4][2];

#define EPI_FENCE() do { asm volatile("" ::: "memory"); __builtin_amdgcn_sched_barrier(0); } while (0)
__device__ __forceinline__ v4u pack8(const f32x4& v0, const f32x4& v1) { v4u w; w.x = cvt_pk_bf16_asm(v0[0], v0[1]); w.y = cvt_pk_bf16_asm(v0[2], v0[3]); w.z = cvt_pk_bf16_asm(v1[0], v1[1]); w.w = cvt_pk_bf16_asm(v1[2], v1[3]); return w; }
struct EpiCols {
    static constexpr bool PERM = true;
    bf16 *cr, *cd, *cm, *ch; const float *cosd, *sind, *cosm, *sinm;
    __device__ __forceinline__ void operator()(AccRef acc, const Unit& u, int wr, int wc, int fr, int fq) const {
        const int pn = u.pn; bf16* base; int ldc, colt;
        if (pn < 4) { base = cr; ldc = 1024; colt = pn * 256; } else if (pn < 7) { base = cd; ldc = 768; colt = (pn - 4) * 256; }
        else if (pn < 9) { base = cm; ldc = 512; colt = (pn - 7) * 256; } else { base = ch; ldc = 1024; colt = (pn - 9) * 256; }
        const int row0 = u.pm * BM + wr * 64 + fr; const int cl0 = wc * 32 + 8 * fq;
        if (pn == 4 || pn == 5) {
            const int j0 = ((cl0 & 63) >> 3) * 4;
            f32x4 nc[4], ns[4];
#pragma unroll
            for (int d = 0; d < 4; ++d) { const int rn = row0 + d * 16; nc[d] = *(const f32x4*)(cosd + (size_t)rn * 32 + j0); ns[d] = *(const f32x4*)(sind + (size_t)rn * 32 + j0); }
#pragma unroll
            for (int gi = 0; gi < 8; ++gi) { const int row = row0 + (gi >> 2) * HALF + (gi & 3) * 16; const f32x4 c = nc[gi & 3], s = ns[gi & 3];
                if (gi < 4) { const int rn = row0 + HALF + gi * 16; nc[gi] = *(const f32x4*)(cosd + (size_t)rn * 32 + j0); ns[gi] = *(const f32x4*)(sind + (size_t)rn * 32 + j0); }
#pragma unroll
                for (int bj = 0; bj < 2; ++bj) { const f32x4 v0 = acc[gi >> 2][bj][gi & 3][0], v1 = acc[gi >> 2][bj][gi & 3][1];
                    *(v4u*)(base + (size_t)row * ldc + colt + bj * HALF + cl0) = pack8(v0 * c - v1 * s, v1 * c + v0 * s); }
                EPI_FENCE(); }
        } else if (pn == 8) {
            const bool rm = cl0 < 32; const int j0 = rm ? (cl0 >> 3) * 4 : 0;
            f32x4 nc[4], ns[4];
#pragma unroll
            for (int d = 0; d < 4; ++d) { const int rn = row0 + d * 16; nc[d] = *(const f32x4*)(cosm + (size_t)rn * 16 + j0); ns[d] = *(const f32x4*)(sinm + (size_t)rn * 16 + j0); }
#pragma unroll
            for (int gi = 0; gi < 8; ++gi) { const int row = row0 + (gi >> 2) * HALF + (gi & 3) * 16; const f32x4 c = nc[gi & 3], s = ns[gi & 3];
                if (gi < 4) { const int rn = row0 + HALF + gi * 16; nc[gi] = *(const f32x4*)(cosm + (size_t)rn * 16 + j0); ns[gi] = *(const f32x4*)(sinm + (size_t)rn * 16 + j0); }
                *(v4u*)(base + (size_t)row * ldc + colt + cl0) = pack8(acc[gi >> 2][0][gi & 3][0], acc[gi >> 2][0][gi & 3][1]);
                f32x4 v0 = acc[gi >> 2][1][gi & 3][0], v1 = acc[gi >> 2][1][gi & 3][1];
                if (rm) { const f32x4 a = v0 * c - v1 * s, b = v1 * c + v0 * s; v0 = a; v1 = b; }
                *(v4u*)(base + (size_t)row * ldc + colt + HALF + cl0) = pack8(v0, v1);
                EPI_FENCE(); }
        } else {
#pragma unroll
            for (int ai = 0; ai < 2; ++ai)
#pragma unroll
                for (int m = 0; m < 4; ++m) { const int row = row0 + ai * HALF + m * 16;
                    *(v4u*)(base + (size_t)row * ldc + colt + cl0) = pack8(acc[ai][0][m][0], acc[ai][0][m][1]);
                    *(v4u*)(base + (size_t)row * ldc + colt + HALF + cl0) = pack8(acc[ai][1][m][0], acc[ai][1][m][1]);
                    EPI_FENCE(); }
        }
    }
};
struct EpiLora {
    static constexpr bool PERM = true;
    bf16* O; const float *w0, *a0;
    __device__ __forceinline__ void operator()(AccRef acc, const Unit& u, int wr, int wc, int fr, int fq) const {
        const int row0 = u.pm * BM + wr * 64 + fr; const int colt = u.pn * BM;
        const float* bias = u.pn == 0 ? w0 : (u.pn == 1 ? a0 : nullptr);
        f32x4 bb[2][2];
#pragma unroll
        for (int bj = 0; bj < 2; ++bj) { const int cl = bj * HALF + wc * 32 + 8 * fq; bb[bj][0] = (f32x4){0.f, 0.f, 0.f, 0.f}; bb[bj][1] = bb[bj][0];
            if (bias) { bb[bj][0] = *(const f32x4*)(bias + cl); bb[bj][1] = *(const f32x4*)(bias + cl + 4); } }
#pragma unroll
        for (int bj = 0; bj < 2; ++bj) { const int cl = bj * HALF + wc * 32 + 8 * fq;
#pragma unroll
            for (int ai = 0; ai < 2; ++ai)
#pragma unroll
                for (int m = 0; m < 4; ++m) { const int row = row0 + ai * HALF + m * 16;
                    *(v4u*)(O + (size_t)row * 768 + colt + cl) = pack8(acc[ai][bj][m][0] + bb[bj][0], acc[ai][bj][m][1] + bb[bj][1]); }
            EPI_FENCE(); }
    }
};
struct EpiMla {
    static constexpr bool PERM = true;
    bf16 *QM, *KVM; const float* rs; const float *cosm, *sinm;
    __device__ __forceinline__ void operator()(AccRef acc, const Unit& u, int wr, int wc, int fr, int fq) const {
        const int row0 = u.pm * BM + wr * 64 + fr;
        int cc_[2], j0_[2]; bool rope_[2];
#pragma unroll
        for (int bj = 0; bj < 2; ++bj) { const int c = u.pn * BM + bj * HALF + wc * 32 + 8 * fq; cc_[bj] = c; const int pos = c % 96; rope_[bj] = (c < 384) && (pos >= 64); j0_[bj] = rope_[bj] ? ((pos - 64) >> 3) * 4 : 0; }
        f32x2 sc[8];
#pragma unroll
        for (int gi = 0; gi < 8; ++gi) sc[gi] = *(const f32x2*)(rs + (size_t)(row0 + (gi >> 2) * HALF + (gi & 3) * 16) * 2);
        f32x4 nc[2][2], ns[2][2];
#pragma unroll
        for (int d = 0; d < 2; ++d)
#pragma unroll
            for (int bj = 0; bj < 2; ++bj) { nc[d][bj] = *(const f32x4*)(cosm + (size_t)(row0 + d * 16) * 16 + j0_[bj]); ns[d][bj] = *(const f32x4*)(sinm + (size_t)(row0 + d * 16) * 16 + j0_[bj]); }
#pragma unroll
        for (int gi = 0; gi < 8; ++gi) { const int ai = gi >> 2, m = gi & 3, row = row0 + ai * HALF + m * 16;
            f32x4 cq[2], sq[2];
#pragma unroll
            for (int bj = 0; bj < 2; ++bj) { cq[bj] = nc[gi & 1][bj]; sq[bj] = ns[gi & 1][bj]; }
            if (gi < 6) { const int rn = row0 + ((gi + 2) >> 2) * HALF + ((gi + 2) & 3) * 16;
#pragma unroll
                for (int bj = 0; bj < 2; ++bj) { nc[gi & 1][bj] = *(const f32x4*)(cosm + (size_t)rn * 16 + j0_[bj]); ns[gi & 1][bj] = *(const f32x4*)(sinm + (size_t)rn * 16 + j0_[bj]); } }
#pragma unroll
            for (int bj = 0; bj < 2; ++bj) { const int c = cc_[bj];
                if (c >= 896) continue;
                f32x4 v0 = acc[ai][bj][m][0], v1 = acc[ai][bj][m][1];
                bf16* dst;
                if (c < 384) { v0 = v0 * sc[gi].x; v1 = v1 * sc[gi].x;
                    if (rope_[bj]) { const f32x4 a = v0 * cq[bj] - v1 * sq[bj], b = v1 * cq[bj] + v0 * sq[bj]; v0 = a; v1 = b; }
                    dst = QM + (size_t)row * 384 + c; }
                else { v0 = v0 * sc[gi].y; v1 = v1 * sc[gi].y; dst = KVM + (size_t)row * 512 + (c - 384); }
                *(v4u*)dst = pack8(v0, v1); }
            EPI_FENCE(); }
    }
};
__device__ __forceinline__ void unpack8(const v4u& w, f32x4& a, f32x4& b) {
    a.x = __builtin_bit_cast(float, w.x << 16); a.y = __builtin_bit_cast(float, w.x & 0xffff0000u); a.z = __builtin_bit_cast(float, w.y << 16); a.w = __builtin_bit_cast(float, w.y & 0xffff0000u);
    b.x = __builtin_bit_cast(float, w.z << 16); b.y = __builtin_bit_cast(float, w.z & 0xffff0000u); b.z = __builtin_bit_cast(float, w.w << 16); b.w = __builtin_bit_cast(float, w.w & 0xffff0000u); }
struct EpiResid {
    static constexpr bool PERM = true;
    const float* res32; const bf16* res; bf16* out;
    __device__ __forceinline__ void operator()(AccRef acc, const Unit& u, int wr, int wc, int fr, int fq) const {
        const int row0 = u.pm * BM + wr * 64 + fr, col0 = u.pn * BM + wc * 32 + 8 * fq;
        const size_t ro0 = (size_t)row0 * 1024 + col0;
        if (res32) {
            f32x4 n[2][2][2];
#pragma unroll
            for (int d = 0; d < 2; ++d) { const size_t rn = ro0 + (size_t)((d >> 2) * HALF + (d & 3) * 16) * 1024;
#pragma unroll
                for (int bj = 0; bj < 2; ++bj) { n[d][bj][0] = *(const f32x4*)(res32 + rn + bj * HALF); n[d][bj][1] = *(const f32x4*)(res32 + rn + bj * HALF + 4); } }
#pragma unroll
            for (int gi = 0; gi < 8; ++gi) { const size_t ro = ro0 + (size_t)((gi >> 2) * HALF + (gi & 3) * 16) * 1024;
                f32x4 r[2][2];
#pragma unroll
                for (int bj = 0; bj < 2; ++bj) { r[bj][0] = n[gi & 1][bj][0]; r[bj][1] = n[gi & 1][bj][1]; }
                if (gi < 6) { const size_t rn = ro0 + (size_t)(((gi + 2) >> 2) * HALF + ((gi + 2) & 3) * 16) * 1024;
#pragma unroll
                    for (int bj = 0; bj < 2; ++bj) { n[gi & 1][bj][0] = *(const f32x4*)(res32 + rn + bj * HALF); n[gi & 1][bj][1] = *(const f32x4*)(res32 + rn + bj * HALF + 4); } }
#pragma unroll
                for (int bj = 0; bj < 2; ++bj) *(v4u*)(out + ro + bj * HALF) = pack8(r[bj][0] + acc[gi >> 2][bj][gi & 3][0], r[bj][1] + acc[gi >> 2][bj][gi & 3][1]);
                EPI_FENCE(); }
        } else {
            v4u w[8][2];
#pragma unroll
            for (int gi = 0; gi < 8; ++gi)
#pragma unroll
                for (int bj = 0; bj < 2; ++bj) w[gi][bj] = *(const v4u*)(res + ro0 + (size_t)((gi >> 2) * HALF + (gi & 3) * 16) * 1024 + bj * HALF);
#pragma unroll
            for (int gi = 0; gi < 8; ++gi) { const size_t ro = ro0 + (size_t)((gi >> 2) * HALF + (gi & 3) * 16) * 1024;
                f32x4 r[2][2];
#pragma unroll
                for (int bj = 0; bj < 2; ++bj) unpack8(w[gi][bj], r[bj][0], r[bj][1]);
#pragma unroll
                for (int bj = 0; bj < 2; ++bj) *(v4u*)(out + ro + bj * HALF) = pack8(r[bj][0] + acc[gi >> 2][bj][gi & 3][0], r[bj][1] + acc[gi >> 2][bj][gi & 3][1]);
                EPI_FENCE(); }
        }
    }
};
struct EpiSwiglu {
    static constexpr bool PERM = true;
    bf16* O; int ldc;
    __device__ __forceinline__ void operator()(AccRef acc, const Unit& u, int wr, int wc, int fr, int fq) const {
        const int row0 = u.pm * BM + wr * 64 + fr, col0 = u.pn * HALF + wc * 32 + 8 * fq;
#pragma unroll
        for (int ai = 0; ai < 2; ++ai)
#pragma unroll
            for (int m = 0; m < 4; ++m) { const int row = row0 + ai * HALF + m * 16;
                float r[8];
#pragma unroll
                for (int n = 0; n < 2; ++n)
#pragma unroll
                    for (int j = 0; j < 4; ++j) { const float gte = acc[ai][0][m][n][j], up = acc[ai][1][m][n][j]; r[n * 4 + j] = gte * frcp(1.0f + fexp(-gte)) * up; }
                v4u w; w.x = cvt_pk_bf16_asm(r[0], r[1]); w.y = cvt_pk_bf16_asm(r[2], r[3]); w.z = cvt_pk_bf16_asm(r[4], r[5]); w.w = cvt_pk_bf16_asm(r[6], r[7]);
                *(v4u*)(O + (size_t)row * ldc + col0) = w;
                EPI_FENCE(); }
    }
};
struct EpiMoeDown {
    static constexpr bool PERM = true;
    const bf16* xs; bf16* xd; const int* rtok; const float* rgate;
    __device__ __forceinline__ void operator()(AccRef acc, const Unit& u, int wr, int wc, int fr, int fq) const {
        const int row0 = u.pm * BM + wr * 64 + fr, col0 = u.pn * BM + wc * 32 + 8 * fq;
        int tk[8]; float gt[8];
#pragma unroll
        for (int gi = 0; gi < 8; ++gi) { const int row = row0 + (gi >> 2) * HALF + (gi & 3) * 16; tk[gi] = rtok[row]; gt[gi] = rgate[row]; }
        asm volatile("" ::: "memory");
        v4u w[4][2];
#pragma unroll
        for (int gi = 0; gi < 4; ++gi) { const size_t rn = (size_t)(tk[gi] < 0 ? 0 : tk[gi]) * 1024 + col0;
#pragma unroll
            for (int bj = 0; bj < 2; ++bj) w[gi][bj] = *(const v4u*)(xs + rn + bj * HALF); }
#pragma unroll
        for (int gi = 0; gi < 8; ++gi) { const int ai = gi >> 2, m = gi & 3;
            f32x4 r[2][2];
#pragma unroll
            for (int bj = 0; bj < 2; ++bj) unpack8(w[gi & 3][bj], r[bj][0], r[bj][1]);
            if (gi < 4) { const size_t rn = (size_t)(tk[gi + 4] < 0 ? 0 : tk[gi + 4]) * 1024 + col0;
#pragma unroll
                for (int bj = 0; bj < 2; ++bj) w[gi & 3][bj] = *(const v4u*)(xs + rn + bj * HALF); }
            if (tk[gi] >= 0) { const size_t ro = (size_t)tk[gi] * 1024 + col0;
#pragma unroll
                for (int bj = 0; bj < 2; ++bj) *(v4u*)(xd + ro + bj * HALF) = pack8(r[bj][0] + acc[ai][bj][m][0] * gt[gi], r[bj][1] + acc[ai][bj][m][1] * gt[gi]); }
            EPI_FENCE(); }
    }
};
struct EpiPartial {
    static constexpr bool PERM = true;
    bf16* part; int first, KS;
    __device__ __forceinline__ void operator()(AccRef acc, const Unit& u, int wr, int wc, int fr, int fq) const {
        bf16* base = part + (size_t)((u.su - first) * KS + u.ks) * 65536; const int r0 = wr * 64 + fr, c0 = wc * 32 + 8 * fq;
#pragma unroll
        for (int ai = 0; ai < 2; ++ai)
#pragma unroll
            for (int m = 0; m < 4; ++m) { bf16* rp = base + (size_t)(r0 + ai * HALF + m * 16) * 256 + c0;
#pragma unroll
                for (int bj = 0; bj < 2; ++bj) *(v4u*)(rp + bj * HALF) = pack8(acc[ai][bj][m][0], acc[ai][bj][m][1]);
                EPI_FENCE(); }
    }
};
}

struct Args { const float* in[31]; float* out; unsigned char* ws; int ph_lo, ph_hi; };
enum { I_X = 0, I_POS, I_MIXN, I_WIN, I_WOUT, I_MU, I_W0, I_W2, I_A0, I_A2, I_G2, I_KK, I_KA, I_RK, I_LNW, I_LNB, I_QN, I_WUQ, I_KVN, I_WUKV, I_LB, I_GN, I_FFNN, I_F1, I_F3, I_F2, I_RT, I_M1, I_M3, I_M2, I_FN };

struct Frame {
    LAS unsigned char* lds; volatile LAS unsigned* MISC; unsigned* ctl;
    int tid, lane, wave, vcu, G;
    unsigned char* ws; float* out;
};
__device__ __forceinline__ unsigned long long ld_u64(const LAS unsigned char* p) { const v2u w = *(const LAS v2u*)p;
    const unsigned lo = __builtin_amdgcn_readfirstlane(w.x), hi = __builtin_amdgcn_readfirstlane(w.y); return ((unsigned long long)hi << 32) | lo; }
#define AIN(i) ((const float*)(const GAS float*)ld_u64(F.lds + ARGS_OFF + 8 * (i)))
__device__ __forceinline__ void frame_init(Frame& F) {
    extern __shared__ __attribute__((aligned(16))) unsigned char lds[];
    F.lds = (LAS unsigned char*)lds; F.MISC = (volatile LAS unsigned*)(F.lds + MISC_OFF);
    { int t_ = threadIdx.x; asm volatile("" : "+v"(t_)); F.tid = t_; } F.lane = F.tid & 63; F.wave = __builtin_amdgcn_readfirstlane(F.tid >> 6);
    F.G = gridDim.x; { const int bx = blockIdx.x; F.vcu = (F.G % 8 == 0) ? (bx % 8) * (F.G / 8) + bx / 8 : bx; }
    F.out = (float*)(GAS float*)ld_u64(F.lds + ARGS_OFF + 8 * 31); F.ws = (unsigned char*)(GAS unsigned char*)ld_u64(F.lds + ARGS_OFF + 8 * 32); F.ctl = (unsigned*)(F.ws + WS_CTL);
}

template <class Map>
__device__ __forceinline__ void tr_load(const Map& mp, f32x4 (&v)[16], int item, int nblk, int lane) {
    const int kb = item / nblk, nb = item % nblk, k0 = 64 * kb, n0 = 64 * nb;
    const int g = lane & 15, r = lane >> 4;
    const float* colp = mp.col(n0 + 4 * g); const size_t ld = mp.ld;
#pragma unroll
    for (int i = 0; i < 16; ++i) v[i] = colp ? *(const f32x4*)(colp + (size_t)(k0 + 4 * i + r) * ld) : (f32x4){0.f, 0.f, 0.f, 0.f};
}
__device__ __forceinline__ void tr_store(const f32x4 (&v)[16], int K, bf16* dst, LAS float* scr, int item, int nblk, int lane) {
    const int kb = item / nblk, nb = item % nblk, k0 = 64 * kb, n0 = 64 * nb;
    const int g = lane & 15, r = lane >> 4;
#pragma unroll
    for (int i = 0; i < 16; ++i) { LAS float* p = scr + (4 * i + r) * 65 + 4 * g; p[0] = v[i].x; p[1] = v[i].y; p[2] = v[i].z; p[3] = v[i].w; }
    LDS_WAIT(); asm volatile("" ::: "memory");
    const int c = lane & 7;
#pragma unroll
    for (int j = 0; j < 8; ++j) { const int n = (lane >> 3) + 8 * j; const LAS float* s = scr + (8 * c) * 65 + n;
        v4u o; o.x = cvt_pk_bf16_asm(s[0 * 65], s[1 * 65]); o.y = cvt_pk_bf16_asm(s[2 * 65], s[3 * 65]); o.z = cvt_pk_bf16_asm(s[4 * 65], s[5 * 65]); o.w = cvt_pk_bf16_asm(s[6 * 65], s[7 * 65]);
        *(v4u*)(dst + (size_t)(n0 + n) * K + k0 + 8 * c) = o; }
    LDS_WAIT(); asm volatile("" ::: "memory");
}
__device__ __forceinline__ int rope_src_dim(int p, int half) { const int g8 = p >> 3, w = p & 7; return (w < 4) ? (4 * g8 + w) : (half + 4 * g8 + (w - 4)); }
struct MapWin { const float* W; size_t ld;
    __device__ __forceinline__ const float* col(int n) const {
        if (n < 1024) return W + n;
        if (n < 1792) { const int q = n - 1024, part = q >> 8, head = (q & 255) >> 6, pos = q & 63; const int dim = (part < 2) ? rope_src_dim(pos, 32) : pos; return W + 1024 + part * 256 + head * 64 + dim; }
        if (n < 2304) { const int q = n - 1792; if (q < 384) return W + 1792 + q; if (q < 416) return W + 2176 + rope_src_dim(q - 384, 16); return nullptr; }
        return W + 2208 + (n - 2304);
    } };
struct MapId { const float* W; size_t ld; __device__ __forceinline__ const float* col(int n) const { return W + n; } };
struct MapW13 { const float *W1, *W3; size_t ld; int noff;
    __device__ __forceinline__ const float* col(int n_) const { const int n = n_ + noff; const int tile = n >> 8, w = n & 255; return (w < 128) ? (W1 + tile * 128 + w) : (W3 + tile * 128 + (w - 128)); } };

template <class Map>
__device__ __forceinline__ void tr_matrix(Frame& F, const Map& mp, int K, int N, bf16* dst) {
    LAS float* scr = (LAS float*)(F.lds + F.wave * 16640);
    const int gw = F.vcu * NWAVES + F.wave, NGW = F.G * NWAVES, nblk = N / 64, nitems = (K / 64) * nblk;
    f32x4 va[16], vb[16];
    if (gw < nitems) tr_load(mp, va, gw, nblk, F.lane);
    for (int it = gw; it < nitems; it += 2 * NGW) {
        const int i1 = it + NGW, i2 = it + 2 * NGW;
        if (i1 < nitems) tr_load(mp, vb, i1, nblk, F.lane);
        tr_store(va, K, dst, scr, it, nblk, F.lane);
        if (i2 < nitems) tr_load(mp, va, i2, nblk, F.lane);
        if (i1 < nitems) tr_store(vb, K, dst, scr, i1, nblk, F.lane);
    }
}

__device__ __forceinline__ float lora_elem(Frame& F, int i) { const int L = i / (768 * 256), r = i % (768 * 256), n = r / 256, k = r % 256; float v = 0.f;
    if (n < 256) { if (k < 64) v = AIN(I_W2)[(size_t)L * 64 * 256 + k * 256 + n]; }
    else if (n < 512) { if (k >= 64 && k < 128) v = AIN(I_A2)[(size_t)L * 64 * 256 + (k - 64) * 256 + (n - 256)]; }
    else { if (k >= 128) v = AIN(I_G2)[(size_t)L * 128 * 256 + (k - 128) * 256 + (n - 512)]; }
    return v; }
__device__ __forceinline__ float mla_elem(Frame& F, int i) { const int L = i / (1024 * 384), r = i % (1024 * 384), n = r / 384, k = r % 384; float v = 0.f;
    if (n < 384) { if (k < 256) { const int head = n / 96, pos = n % 96; const int sc = (pos < 64) ? pos : 64 + rope_src_dim(pos - 64, 16);
            v = AIN(I_QN)[L * 256 + k] * AIN(I_WUQ)[(size_t)L * 256 * 384 + (size_t)k * 384 + head * 96 + sc]; } }
    else if (n < 896) { if (k >= 256) v = AIN(I_KVN)[L * 128 + (k - 256)] * AIN(I_WUKV)[(size_t)L * 128 * 512 + (size_t)(k - 256) * 512 + (n - 384)]; }
    return v; }
__device__ __forceinline__ void p_blockmats(Frame& F) {
    unsigned char* ws = F.ws;
    const int gt = F.vcu * (NWAVES * 64) + F.tid, NGT = F.G * NWAVES * 64;
    for (int i = gt; i < DEPTH * 768 * 256; i += 4 * NGT) { float v[4];
#pragma unroll
        for (int q = 0; q < 4; ++q) v[q] = (i + q * NGT < DEPTH * 768 * 256) ? lora_elem(F, i + q * NGT) : 0.f;
#pragma unroll
        for (int q = 0; q < 4; ++q) if (i + q * NGT < DEPTH * 768 * 256) ((bf16*)(ws + WS_WLORA))[i + q * NGT] = (bf16)f2bf(v[q]); }
    for (int i = gt; i < DEPTH * 1024 * 384; i += 4 * NGT) { float v[4];
#pragma unroll
        for (int q = 0; q < 4; ++q) v[q] = (i + q * NGT < DEPTH * 1024 * 384) ? mla_elem(F, i + q * NGT) : 0.f;
#pragma unroll
        for (int q = 0; q < 4; ++q) if (i + q * NGT < DEPTH * 1024 * 384) ((bf16*)(ws + WS_WMLA))[i + q * NGT] = (bf16)f2bf(v[q]); }
}
__device__ __forceinline__ void p_prologue(Frame& F) {
    unsigned char* ws = F.ws;
    { MapWin mp{AIN(I_WIN), (size_t)NIN}; tr_matrix(F, mp, D, NINP, (bf16*)(ws + WS_WIN)); }
    const int gt = F.vcu * (NWAVES * 64) + F.tid, NGT = F.G * NWAVES * 64;
    float* cosd = (float*)(ws + WS_ROPE); float* sind = cosd + (size_t)M * 32; float* cosm = sind + (size_t)M * 32; float* sinm = cosm + (size_t)M * 16;
    const int* pos = (const int*)AIN(I_POS);
    for (int i0 = gt; i0 < M * 48; i0 += 4 * NGT) {
        int ps[4];
#pragma unroll
        for (int q = 0; q < 4; ++q) ps[q] = pos[(i0 + q * NGT) / 48];
#pragma unroll
        for (int q = 0; q < 4; ++q) { const int i = i0 + q * NGT; const int row = i / 48, j = i % 48; const bool dd = j < 32; const int jj = dd ? j : j - 32;
            const float invf = __builtin_amdgcn_exp2f(-(float)jj * (dd ? (13.287712379549449f / 32.0f) : (13.287712379549449f / 16.0f)));
            const double ang = (double)ps[q] * (double)invf; double rev = ang * 0.15915494309189535; rev -= __builtin_rint(rev);
            const float fr = (float)rev; const float s = __builtin_amdgcn_sinf(fr), c = __builtin_amdgcn_cosf(fr);
            if (dd) { cosd[(size_t)row * 32 + jj] = c; sind[(size_t)row * 32 + jj] = s; } else { cosm[(size_t)row * 16 + jj] = c; sinm[(size_t)row * 16 + jj] = s; } } }
}
__device__ __forceinline__ bf16* wm13_base(int e, unsigned char* ws, float* out) {
    return e < 4 ? (bf16*)out + (size_t)e * 2 * FFE * D : (bf16*)(ws + (e == 4 ? 444 * MiB : (e == 5 ? 21 * MiB : (e == 6 ? 1 * MiB : 35 * MiB)))); }
__device__ __forceinline__ void p_moe_weights(Frame& F, Frame& G, int e0, int e1) {
    for (int e = e0; e < e1; ++e) { MapW13 mp{AIN(I_M1) + (size_t)e * D * FFE, AIN(I_M3) + (size_t)e * D * FFE, (size_t)FFE, 0}; tr_matrix(G, mp, D, 2 * FFE, wm13_base(e, F.ws, F.out)); }
}
__device__ __forceinline__ void p_moe_weights2(Frame& F) {
    Frame G2 = F; G2.vcu = F.vcu - 128; G2.G = 128;
    { MapW13 mp{AIN(I_F1), AIN(I_F3), (size_t)FF, 0}; tr_matrix(G2, mp, D, 2 * FF, (bf16*)(F.ws + WS_W13D)); }
    { MapId mp{AIN(I_F2), (size_t)D}; tr_matrix(G2, mp, FF, D, (bf16*)(F.ws + WS_W2D)); }
    { MapWin mp{AIN(I_WIN) + (size_t)D * NIN, (size_t)NIN}; tr_matrix(G2, mp, D, NINP, (bf16*)(F.ws + WS_WIN) + (size_t)NINP * D); }
    { MapId mp{AIN(I_WOUT), (size_t)D}; tr_matrix(G2, mp, D, D, (bf16*)(F.ws + WS_WOUT)); }
    { MapId mp{AIN(I_WOUT) + (size_t)D * D, (size_t)D}; tr_matrix(G2, mp, D, D, (bf16*)(F.ws + WS_WOUT) + (size_t)D * D); }
    for (int e = 0; e < NEXP; ++e) { MapId mp{AIN(I_M2) + (size_t)e * FFE * D, (size_t)D}; tr_matrix(G2, mp, FFE, D, (bf16*)(F.ws + WS_WM2) + (size_t)e * D * FFE); }
}

__device__ __forceinline__ void norm_rows(Frame& F, const float* x, const float* gain, bf16* h) {
    const int gw = F.vcu * NWAVES + F.wave, NGW = F.G * NWAVES;
    f32x4 gv[4];
#pragma unroll
    for (int j = 0; j < 4; ++j) gv[j] = *(const f32x4*)(gain + 4 * F.lane + 256 * j);
    for (int m0 = gw; m0 < M; m0 += 4 * NGW) {
        f32x4 v[4][4]; float s[4];
#pragma unroll
        for (int q = 0; q < 4; ++q) { const f32x4* xr = (const f32x4*)(x + (size_t)(m0 + q * NGW) * D) + F.lane;
#pragma unroll
            for (int j = 0; j < 4; ++j) v[q][j] = xr[64 * j]; }
#pragma unroll
        for (int q = 0; q < 4; ++q) { s[q] = 0.f;
#pragma unroll
            for (int j = 0; j < 4; ++j) s[q] += (v[q][j].x * v[q][j].x + v[q][j].y * v[q][j].y) + (v[q][j].z * v[q][j].z + v[q][j].w * v[q][j].w); }
#pragma unroll
        for (int q = 0; q < 4; ++q) s[q] = wave_sum(s[q]);
#pragma unroll
        for (int q = 0; q < 4; ++q) { const float r = __builtin_amdgcn_rsqf(s[q] * (1.f / D) + 1e-6f);
            v2u* o = (v2u*)(h + (size_t)(m0 + q * NGW) * D) + F.lane;
#pragma unroll
            for (int j = 0; j < 4; ++j) { const f32x4 y = v[q][j] * r * gv[j]; v2u w; w.x = pk2(y.x, y.y); w.y = pk2(y.z, y.w); o[64 * j] = w; } }
    }
}
__device__ __forceinline__ void norm_rows_b(Frame& F, const bf16* x, const float* gain, bf16* h) {
    const int gw = F.vcu * NWAVES + F.wave, NGW = F.G * NWAVES;
    f32x4 gv[2][2];
#pragma unroll
    for (int j = 0; j < 2; ++j) { gv[j][0] = *(const f32x4*)(gain + 8 * F.lane + 512 * j); gv[j][1] = *(const f32x4*)(gain + 8 * F.lane + 512 * j + 4); }
    for (int m0 = gw; m0 < M; m0 += 4 * NGW) {
        v4u w[4][2]; float s[4];
#pragma unroll
        for (int q = 0; q < 4; ++q) { const v4u* xr = (const v4u*)(x + (size_t)(m0 + q * NGW) * D) + F.lane; w[q][0] = xr[0]; w[q][1] = xr[64]; }
#pragma unroll
        for (int q = 0; q < 4; ++q) { s[q] = 0.f;
#pragma unroll
            for (int j = 0; j < 2; ++j) { f32x4 a, b; pg8::unpack8(w[q][j], a, b); s[q] += ((a.x * a.x + a.y * a.y) + (a.z * a.z + a.w * a.w)) + ((b.x * b.x + b.y * b.y) + (b.z * b.z + b.w * b.w)); } }
#pragma unroll
        for (int q = 0; q < 4; ++q) s[q] = wave_sum(s[q]);
#pragma unroll
        for (int q = 0; q < 4; ++q) { const float r = __builtin_amdgcn_rsqf(s[q] * (1.f / D) + 1e-6f);
            v4u* o = (v4u*)(h + (size_t)(m0 + q * NGW) * D) + F.lane;
#pragma unroll
            for (int j = 0; j < 2; ++j) { f32x4 a, b; pg8::unpack8(w[q][j], a, b); const f32x4 y0 = a * r * gv[j][0], y1 = b * r * gv[j][1];
                v4u ow; ow.x = pk2(y0.x, y0.y); ow.y = pk2(y0.z, y0.w); ow.z = pk2(y1.x, y1.y); ow.w = pk2(y1.z, y1.w); o[64 * j] = ow; } }
    }
}
__device__ __forceinline__ void final_norm_rows(Frame& F, const bf16* x, float* out, const float* gain) {
    const int gw = F.vcu * NWAVES + F.wave, NGW = F.G * NWAVES;
    f32x4 gv[2][2];
#pragma unroll
    for (int j = 0; j < 2; ++j) { gv[j][0] = *(const f32x4*)(gain + 8 * F.lane + 512 * j); gv[j][1] = *(const f32x4*)(gain + 8 * F.lane + 512 * j + 4); }
    for (int m0 = gw; m0 < M; m0 += 4 * NGW) {
        v4u w[4][2]; float s[4];
#pragma unroll
        for (int q = 0; q < 4; ++q) { const v4u* xr = (const v4u*)(x + (size_t)(m0 + q * NGW) * D) + F.lane; w[q][0] = xr[0]; w[q][1] = xr[64]; }
#pragma unroll
        for (int q = 0; q < 4; ++q) { s[q] = 0.f;
#pragma unroll
            for (int j = 0; j < 2; ++j) { f32x4 a, b; pg8::unpack8(w[q][j], a, b); s[q] += ((a.x * a.x + a.y * a.y) + (a.z * a.z + a.w * a.w)) + ((b.x * b.x + b.y * b.y) + (b.z * b.z + b.w * b.w)); } }
#pragma unroll
        for (int q = 0; q < 4; ++q) s[q] = wave_sum(s[q]);
#pragma unroll
        for (int q = 0; q < 4; ++q) { const float r = __builtin_amdgcn_rsqf(s[q] * (1.f / D) + 1e-6f);
            float* o = out + (size_t)(m0 + q * NGW) * D + 8 * F.lane;
#pragma unroll
            for (int j = 0; j < 2; ++j) { f32x4 a, b; pg8::unpack8(w[q][j], a, b); *(f32x4*)(o + 512 * j) = a * r * gv[j][0]; *(f32x4*)(o + 512 * j + 4) = b * r * gv[j][1]; } }
    }
}
__device__ __forceinline__ void norm_router(Frame& F, const bf16* x, const float* gain, const float* wr, bf16* h) {
    LAS int* lcnt = (LAS int*)(F.lds + 32768);
    LAS int* lbase = lcnt + 16;
    LAS int* lrow = lcnt + 32;
    f32x4 wra[16], wrb[16];
#pragma unroll
    for (int q = 0; q < 16; ++q) { const int k = 8 * F.lane + 512 * (q >> 3) + (q & 7); wra[q] = *(const f32x4*)(wr + k * 8); wrb[q] = *(const f32x4*)(wr + k * 8 + 4); }
    if (F.tid < 16) lcnt[F.tid] = 0;
    int* rtok = (int*)(F.ws + MS_RTOK); const int gt = F.vcu * 512 + F.tid;
    for (int i = gt; i < 2 * MAXROWS; i += F.G * 512) rtok[i] = -1;
    __syncthreads();
    f32x4 gv[4];
#pragma unroll
    for (int j = 0; j < 4; ++j) gv[j] = *(const f32x4*)(gain + 8 * F.lane + 512 * (j >> 1) + 4 * (j & 1));
    int* tope = (int*)(F.ws + MS_TOPE); float* gate = (float*)(F.ws + MS_GATE); int* rank = (int*)(F.ws + MS_RANK);
    const int rb = blockIdx.x * 128;
    v4u nw0, nw1; { const v4u* xr = (const v4u*)(x + (size_t)(rb + F.wave * 16) * D) + F.lane; nw0 = xr[0]; nw1 = xr[64]; }
    for (int q = 0; q < 16; ++q) { const int lr = F.wave * 16 + q, m = rb + lr;
        f32x4 v[4]; float s = 0.f;
        { const v4u w0 = nw0, w1 = nw1;
          const v4u* xn = (const v4u*)(x + (size_t)(q < 15 ? m + 1 : m) * D) + F.lane; nw0 = xn[0]; nw1 = xn[64];
          pg8::unpack8(w0, v[0], v[1]); pg8::unpack8(w1, v[2], v[3]); }
#pragma unroll
        for (int j = 0; j < 4; ++j) s += (v[j].x * v[j].x + v[j].y * v[j].y) + (v[j].z * v[j].z + v[j].w * v[j].w);
        const float r = __builtin_amdgcn_rsqf(wave_sum(s) * (1.f / D) + 1e-6f);
        float lg[8];
#pragma unroll
        for (int e = 0; e < 8; ++e) lg[e] = 0.f;
        v2u* o = (v2u*)(h + (size_t)m * D + 8 * F.lane);
#pragma unroll
        for (int j = 0; j < 4; ++j) { const f32x4 y = v[j] * r * gv[j]; v2u w; w.x = pk2(y.x, y.y); w.y = pk2(y.z, y.w); o[128 * (j >> 1) + (j & 1)] = w;
#pragma unroll
            for (int c = 0; c < 4; ++c) { const f32x4 wa = wra[(j >> 1) * 8 + (j & 1) * 4 + c], wb = wrb[(j >> 1) * 8 + (j & 1) * 4 + c];
                lg[0] += y[c] * wa.x; lg[1] += y[c] * wa.y; lg[2] += y[c] * wa.z; lg[3] += y[c] * wa.w; lg[4] += y[c] * wb.x; lg[5] += y[c] * wb.y; lg[6] += y[c] * wb.z; lg[7] += y[c] * wb.w; } }
#pragma unroll
        for (int e = 0; e < 8; ++e) lg[e] = wave_sum(lg[e]);
        int e0 = 0; float v0 = lg[0];
#pragma unroll
        for (int e = 1; e < 8; ++e) if (lg[e] > v0) { v0 = lg[e]; e0 = e; }
        int e1 = -1; float v1 = -3.0e38f;
#pragma unroll
        for (int e = 0; e < 8; ++e) if (e != e0 && lg[e] > v1) { v1 = lg[e]; e1 = e; }
        if (F.lane == 0) { const float g1 = frcp(1.0f + fexp(v0 - v1)); const float g0 = 1.0f - g1;
            const int r0 = atomicAdd((int*)&lcnt[e0], 1), r1 = atomicAdd((int*)&lcnt[8 + e1], 1);
            lrow[lr * 4 + 0] = e0; lrow[lr * 4 + 1] = e1; lrow[lr * 4 + 2] = r0; lrow[lr * 4 + 3] = r1;
            tope[m * 2] = e0; tope[m * 2 + 1] = e1; gate[m * 2] = g0; gate[m * 2 + 1] = g1; }
    }
    __syncthreads();
    if (F.tid < 16) lbase[F.tid] = (int)atomicAdd(F.ctl + CW_CNT + F.tid, (unsigned)lcnt[F.tid]);
    __syncthreads();
    if (F.tid < 128) { const int m = rb + F.tid; rank[m * 2] = lbase[lrow[F.tid * 4]] + lrow[F.tid * 4 + 2]; rank[m * 2 + 1] = lbase[8 + lrow[F.tid * 4 + 1]] + lrow[F.tid * 4 + 3]; }
    __syncthreads();
}
__device__ __forceinline__ int moe_tables(Frame& F, int s, LAS int* tstart, LAS int* texp) {
    __syncthreads();
    if (F.wave == 0) {
        int nt = 0;
        if (F.lane < 8) { const int c = (int)__hip_atomic_load(F.ctl + CW_CNT + s * 8 + F.lane, __ATOMIC_RELAXED, __HIP_MEMORY_SCOPE_AGENT); nt = (c + 255) >> 8; }
        int inc = nt;
#pragma unroll
        for (int d = 1; d < 8; d <<= 1) { const int v = __shfl_up(inc, d); if (F.lane >= d) inc += v; }
        if (F.lane < 8) tstart[F.lane] = inc - nt;
        int incs[8];
#pragma unroll
        for (int e = 0; e < 8; ++e) incs[e] = __shfl(inc, e);
        const int total = incs[7];
        if (F.lane == 0) tstart[8] = total > MAXT ? MAXT : total;
#pragma clang loop vectorize(disable) unroll(disable)
        for (int t = F.lane; t < MAXT; t += 64) { int e = 0;
#pragma unroll
            for (int k = 0; k < 8; ++k) e += (t >= incs[k]) ? 1 : 0;
            if (t < total) texp[t] = e; } }
    __syncthreads();
    return tstart[8];
}
__device__ __forceinline__ void moe_scatter(Frame& F) {
    LAS int* tst = (LAS int*)(F.lds + 1024); LAS int* texp = (LAS int*)(F.lds + 2048);
    const int* tope = (const int*)(F.ws + MS_TOPE); const float* gate = (const float*)(F.ws + MS_GATE); const int* rank = (const int*)(F.ws + MS_RANK);
    int* rtok = (int*)(F.ws + MS_RTOK); float* rgate = (float*)(F.ws + MS_RGATE);
    int st0[8], st1[8];
    moe_tables(F, 0, tst, texp);
#pragma unroll
    for (int e = 0; e < 8; ++e) st0[e] = tst[e];
    moe_tables(F, 1, tst, texp);
#pragma unroll
    for (int e = 0; e < 8; ++e) st1[e] = tst[e];
    const int gt = F.vcu * 512 + F.tid;
    for (int m = gt; m < M; m += F.G * 512) {
        const int e0 = tope[m * 2], e1 = tope[m * 2 + 1];
        int b0 = 0, b1 = 0;
#pragma unroll
        for (int e = 0; e < 8; ++e) { b0 = (e == e0) ? st0[e] : b0; b1 = (e == e1) ? st1[e] : b1; }
        const int p0 = b0 * 256 + rank[m * 2], p1 = b1 * 256 + rank[m * 2 + 1];
        if (p0 < MAXROWS) { rtok[p0] = m; rgate[p0] = gate[m * 2]; }
        if (p1 < MAXROWS) { rtok[MAXROWS + p1] = m; rgate[MAXROWS + p1] = gate[m * 2 + 1]; }
    }
}

__device__ __forceinline__ void p_prepA(Frame& F, int L) {
    const bf16* cr = (const bf16*)(F.ws + WS_CR); const bf16* cm = (const bf16*)(F.ws + WS_CM);
    bf16* al = (bf16*)(F.ws + WS_AL); float* rs = (float*)(F.ws + MS_RS);
    const float* mu = AIN(I_MU) + L * 1024 + 768;
    const int gw = F.vcu * NWAVES + F.wave, NGW = F.G * NWAVES;
    f32x4 muv = *(const f32x4*)(mu + 4 * F.lane);
    for (int m0 = gw; m0 < M; m0 += 4 * NGW) {
        v2u cw[4], pw[4], qq[4]; unsigned kv[4]; float sq[4], sk[4];
#pragma unroll
        for (int r = 0; r < 4; ++r) { const int m = m0 + r * NGW; const int t = m & (T - 1);
            cw[r] = *(const v2u*)(cr + (size_t)m * 1024 + 768 + 4 * F.lane);
            pw[r] = (v2u){0u, 0u}; if (t > 0) pw[r] = *(const v2u*)(cr + (size_t)(m - 1) * 1024 + 768 + 4 * F.lane);
            qq[r] = *(const v2u*)(cm + (size_t)m * 512 + 4 * F.lane);
            kv[r] = *(const unsigned*)(cm + (size_t)m * 512 + 256 + 2 * F.lane); }
#pragma unroll
        for (int r = 0; r < 4; ++r) { const int m = m0 + r * NGW;
            float c[4] = {bflo(cw[r].x), bfhi(cw[r].x), bflo(cw[r].y), bfhi(cw[r].y)}, p[4] = {bflo(pw[r].x), bfhi(pw[r].x), bflo(pw[r].y), bfhi(pw[r].y)}, o[4];
#pragma unroll
            for (int j = 0; j < 4; ++j) { const float xs = c[j] + (p[j] - c[j]) * muv[j]; const int col = 4 * F.lane + j; o[j] = (col < 64) ? tanhf_(xs) : ((col < 128) ? xs : sigmoidf_(xs)); }
            v2u w; w.x = pk2(o[0], o[1]); w.y = pk2(o[2], o[3]); *(v2u*)(al + (size_t)m * 256 + 4 * F.lane) = w;
            sq[r] = bflo(qq[r].x) * bflo(qq[r].x) + bfhi(qq[r].x) * bfhi(qq[r].x) + bflo(qq[r].y) * bflo(qq[r].y) + bfhi(qq[r].y) * bfhi(qq[r].y);
            sk[r] = bflo(kv[r]) * bflo(kv[r]) + bfhi(kv[r]) * bfhi(kv[r]); }
#pragma unroll
        for (int r = 0; r < 4; ++r) { sq[r] = wave_sum(sq[r]); sk[r] = wave_sum(sk[r]); }
#pragma unroll
        for (int r = 0; r < 4; ++r) { const int m = m0 + r * NGW;
            if (F.lane == 0) { rs[m * 2] = __builtin_amdgcn_rsqf(sq[r] * (1.f / 256.f) + 1e-6f); rs[m * 2 + 1] = __builtin_amdgcn_rsqf(sk[r] * (1.f / 128.f) + 1e-6f); } }
    }
}
__device__ __forceinline__ void unpk4(const v2u w, float (&o)[4]) { o[0] = bflo(w.x); o[1] = bfhi(w.x); o[2] = bflo(w.y); o[3] = bfhi(w.y); }
__device__ __forceinline__ v2u pk4(const float (&o)[4]) { v2u w; w.x = pk2(o[0], o[1]); w.y = pk2(o[2], o[3]); return w; }
typedef short s16x4v __attribute__((ext_vector_type(4)));
__device__ __forceinline__ f32x4 mfma16(const v2u a, const v2u b, const f32x4 c) { return __builtin_amdgcn_mfma_f32_16x16x32_bf16(__builtin_bit_cast(bf16x8, ((v4u){a.x, a.y, 0u, 0u})), __builtin_bit_cast(bf16x8, ((v4u){b.x, b.y, 0u, 0u})), c, 0, 0, 0); }
__device__ __forceinline__ f32x4 mfma32(const v4u a, const v4u b, const f32x4 c) { return __builtin_amdgcn_mfma_f32_16x16x32_bf16(__builtin_bit_cast(bf16x8, a), __builtin_bit_cast(bf16x8, b), c, 0, 0, 0); }
constexpr int SPL_IMG = 16 * 144, SPL_KPT = 5 * SPL_IMG, SPL_AL = SPL_KPT + 64 * 40, SPL_TI = SPL_AL + 1024, SPL_WAVE = SPL_TI + 512;
static_assert(8 * SPL_WAVE + 8 * 512 <= RING_BYTES, "scan precompute LDS");
struct SpRaw { v4u a[5][2]; float prm[6]; unsigned short prev[3]; };
__device__ __forceinline__ void sp_fetch(SpRaw& o, Frame& F, int L, int it, int lane) {
    const int head8 = it >> 11, b = (it >> 7) & 15, chunk = it & 127; const bool rw = head8 < 4; const int hd = head8 & 3;
    const size_t m0 = (size_t)b * T + chunk * 16; const int rowi = lane >> 3, c8 = lane & 7; const int ch = hd * 64 + lane;
    if (rw) { const unsigned short* crc = (const unsigned short*)(F.ws + WS_CR) + ch; const size_t mp = chunk > 0 ? m0 - 1 : m0;
        o.prm[0] = AIN(I_MU)[L * 1024 + ch]; o.prm[1] = AIN(I_MU)[L * 1024 + 256 + ch]; o.prm[2] = AIN(I_MU)[L * 1024 + 512 + ch]; o.prm[3] = AIN(I_KK)[L * 256 + ch]; o.prm[4] = AIN(I_KA)[L * 256 + ch]; o.prm[5] = AIN(I_RK)[L * 256 + ch];
        o.prev[0] = crc[mp * 1024]; o.prev[1] = crc[mp * 1024 + 256]; o.prev[2] = crc[mp * 1024 + 512]; }
    else { o.prm[0] = AIN(I_LB)[256 + ch]; o.prm[1] = AIN(I_LB)[ch]; }
    if (rw) { const bf16* cr = (const bf16*)(F.ws + WS_CR) + hd * 64 + c8 * 8; const bf16* lo = (const bf16*)(F.ws + WS_LO) + hd * 64 + c8 * 8;
#pragma unroll
        for (int j = 0; j < 2; ++j) { const size_t m = m0 + 8 * j + rowi;
            o.a[0][j] = *(const v4u*)(cr + m * 1024); o.a[1][j] = *(const v4u*)(cr + m * 1024 + 256); o.a[2][j] = *(const v4u*)(cr + m * 1024 + 512);
            o.a[3][j] = *(const v4u*)(lo + m * 768); o.a[4][j] = *(const v4u*)(lo + m * 768 + 256); }
    } else { const bf16* chh = (const bf16*)(F.ws + WS_CH) + hd * 64 + c8 * 8;
#pragma unroll
        for (int j = 0; j < 2; ++j) { const size_t m = m0 + 8 * j + rowi;
            o.a[0][j] = *(const v4u*)(chh + m * 1024); o.a[1][j] = *(const v4u*)(chh + m * 1024 + 256); o.a[2][j] = *(const v4u*)(chh + m * 1024 + 512); o.a[3][j] = o.a[0][j]; o.a[4][j] = o.a[0][j]; } }
}
template <bool RW>
__device__ __forceinline__ void sp_item(Frame& F, int L, LAS unsigned char* wl, int it, int b, int hd, int chunk, int lane, const float (&prm)[6], const unsigned short (&prev)[3]) {
    LAS bf16* RpI = (LAS bf16*)wl; LAS bf16* KqI = (LAS bf16*)(wl + SPL_IMG); LAS bf16* AqI = (LAS bf16*)(wl + 2 * SPL_IMG); LAS bf16* KpI = (LAS bf16*)(wl + 3 * SPL_IMG); LAS bf16* UaI = (LAS bf16*)(wl + 4 * SPL_IMG);
    LAS unsigned char* KpT = wl + SPL_KPT; LAS float* AL = (LAS float*)(wl + SPL_AL); LAS bf16* TI = (LAS bf16*)(wl + SPL_TI);
    const bf16* cr = (const bf16*)(F.ws + WS_CR);
    bf16* gRp = (bf16*)(F.ws + SP_RP); bf16* gKqT = (bf16*)(F.ws + SP_KQT); bf16* gE = (bf16*)(F.ws + SP_E); float* gPC = (float*)(F.ws + SP_PC); float* gBS = (float*)(F.ws + SP_BS);
    bf16* gVT = (bf16*)(F.ws + SP_VT); bf16* gK2 = (bf16*)(F.ws + SP_K2); bf16* gTB = (bf16*)(F.ws + SP_TB); bf16* gFm = (bf16*)(F.ws + SP_FM); bf16* gAqT = (bf16*)(F.ws + SP_AQT);
    const int row = lane & 15, g = lane >> 4, ch = hd * 64 + lane; (void)it; (void)UaI; (void)KpI; (void)KpT; (void)AL; (void)TI; (void)gBS; (void)gK2; (void)gTB; (void)gFm; (void)gAqT; (void)cr;
    const size_t m0 = (size_t)b * T + chunk * 16; const int ridx = (b * 4 + hd) * 128 + chunk, cidx = (b * 8 + (RW ? hd : 4 + hd)) * 128 + chunk; (void)ridx;
        float mur = 0.f, muk = 0.f, muv = 0.f, kkp = 0.f, kap_ = 0.f, rkp = 0.f, lb = 0.f;
        float pr = 0.f, pk = 0.f, pv = 0.f;
        if (RW) { mur = prm[0]; muk = prm[1]; muv = prm[2]; kkp = prm[3]; kap_ = prm[4]; rkp = prm[5];
            if (chunk > 0) { pr = bf2f(prev[0]); pk = bf2f(prev[1]); pv = bf2f(prev[2]); } }
        if (!RW && L == 1) lb = sigmoidf_(prm[0] - prm[1]);
        asm volatile("s_waitcnt lgkmcnt(0)" ::: "memory");
        float P = 1.0f, bsv = 0.f;
        unsigned kqT[8], aqT[8], vT[8], kpT[8];
#pragma unroll
        for (int t = 0; t < 16; ++t) {
            float r, w, kq_, v, kap, at;
            const float x0 = bf2f(RpI[t * 72 + lane]), x1 = bf2f(KqI[t * 72 + lane]), x2 = bf2f(AqI[t * 72 + lane]);
            if (RW) { const float c_r = x0, c_k = x1, c_v = x2; const float uw = bf2f(KpI[t * 72 + lane]), ua = bf2f(UaI[t * 72 + lane]);
                r = c_r + (pr - c_r) * mur; const float k = c_k + (pk - c_k) * muk; v = c_v + (pv - c_v) * muv; pr = c_r; pk = c_k; pv = c_v;
                w = fexp(-0.6065306597126334f * sigmoidf_(uw)); const float aa = sigmoidf_(ua);
                const float kk = k * kkp; kap = kk * fminf(__builtin_amdgcn_rsqf(wave_sum_dpp(kk * kk)), 1e12f);
                kq_ = k * (1.0f + (aa - 1.0f) * kap_); at = kap * aa;
                const float bs = wave_sum_dpp(r * kq_ * rkp); bsv = (lane == t) ? bs : bsv; }
            else { r = siluf_(x0); w = lb + (1.0f - lb) * sigmoidf_(x1); kq_ = 1.0f - w; v = x2; kap = 0.f; at = 0.f; }
            const float Pm1 = P; P = fmaxf(P * w, 1e-30f); const float iP = frcp(P);
            const unsigned w0_ = cvt_pk_bf16(r * P, kap * Pm1), w1_ = cvt_pk_bf16(kq_ * iP, at * iP), w2_ = cvt_pk_bf16(v, 0.f);
            const unsigned rp_b = w0_ & 0xffffu, kp_b = w0_ >> 16, kq_b = w1_ & 0xffffu, aq_b = w1_ >> 16, v_b = w2_ & 0xffffu;
            RpI[t * 72 + lane] = (bf16)rp_b; KqI[t * 72 + lane] = (bf16)kq_b;
            if (RW) { KpI[t * 72 + lane] = (bf16)kp_b; AqI[t * 72 + lane] = (bf16)aq_b; }
            if (t & 1) { kqT[t >> 1] |= kq_b << 16; aqT[t >> 1] |= aq_b << 16; vT[t >> 1] |= v_b << 16; kpT[t >> 1] |= kp_b << 16; }
            else { kqT[t >> 1] = kq_b; aqT[t >> 1] = aq_b; vT[t >> 1] = v_b; kpT[t >> 1] = kp_b; }
        }
        asm volatile("" ::: "memory");
        gPC[(size_t)cidx * 64 + lane] = P;
        const unsigned fto = (unsigned)((lane >> 4) * 512 + (lane & 15) * 8);
#pragma unroll
        for (int gq = 0; gq < 4; ++gq) { *(v2u*)((char*)gKqT + (size_t)cidx * 2048 + fto + 128 * gq) = (v2u){kqT[2 * gq], kqT[2 * gq + 1]}; *(v2u*)((char*)gVT + (size_t)cidx * 2048 + fto + 128 * gq) = (v2u){vT[2 * gq], vT[2 * gq + 1]}; }
#pragma unroll
        for (int pr = 0; pr < 2; ++pr) { const v2u a_ = *(const LAS v2u*)((const LAS unsigned char*)RpI + row * 144 + (32 * pr + 4 * g) * 2), b_ = *(const LAS v2u*)((const LAS unsigned char*)RpI + row * 144 + (32 * pr + 16 + 4 * g) * 2);
            *(v4u*)((char*)gRp + (size_t)cidx * 2048 + pr * 1024 + lane * 16) = (v4u){a_.x, a_.y, b_.x, b_.y}; }
        v4u rpA[2], kqB[2];
#pragma unroll
        for (int s = 0; s < 2; ++s) { rpA[s] = *(const LAS v4u*)((const LAS unsigned char*)RpI + row * 144 + (8 * g + 32 * s) * 2); kqB[s] = *(const LAS v4u*)((const LAS unsigned char*)KqI + row * 144 + (8 * g + 32 * s) * 2); }
        f32x4 Em = (f32x4){0.f, 0.f, 0.f, 0.f}; Em = mfma32(rpA[0], kqB[0], Em); Em = mfma32(rpA[1], kqB[1], Em);
        LAS unsigned short* fimg = (LAS unsigned short*)(F.lds + 8 * SPL_WAVE + F.wave * 512);
#define SP_PUT16(gdst, idx512, expr) do { _Pragma("unroll") for (int q = 0; q < 4; ++q) fimg[((row >> 2) * 16 + 4 * g + q) * 4 + (row & 3)] = (unsigned short)f2bf(expr); \
        asm volatile("s_waitcnt lgkmcnt(0)" ::: "memory"); const v2u w_ = *(const LAS v2u*)((const LAS unsigned char*)fimg + lane * 8); asm volatile("s_waitcnt lgkmcnt(0)" ::: "memory"); \
        *(v2u*)((char*)(gdst) + (size_t)(idx512) * 512 + lane * 8) = w_; } while (0)
        SP_PUT16(gE, cidx, (row <= 4 * g + q) ? Em[q] : 0.f);
        if (RW) {
            if (lane < 16) gBS[(size_t)ridx * 16 + lane] = bsv;
#pragma unroll
            for (int gq = 0; gq < 4; ++gq) *(v2u*)((char*)gAqT + (size_t)ridx * 2048 + fto + 128 * gq) = (v2u){aqT[2 * gq], aqT[2 * gq + 1]};
#pragma unroll
            for (int q = 0; q < 4; ++q) *(LAS v2u*)(KpT + lane * 40 + q * 8) = (v2u){kpT[2 * q], kpT[2 * q + 1]};
            asm volatile("" ::: "memory");
            v4u kpA[2], aqB[2];
#pragma unroll
            for (int s = 0; s < 2; ++s) { kpA[s] = *(const LAS v4u*)((const LAS unsigned char*)KpI + row * 144 + (8 * g + 32 * s) * 2); aqB[s] = *(const LAS v4u*)((const LAS unsigned char*)AqI + row * 144 + (8 * g + 32 * s) * 2); }
            f32x4 Am = (f32x4){0.f, 0.f, 0.f, 0.f}, Bm = Am, Fmm = Am;
            Am = mfma32(kpA[0], aqB[0], Am); Am = mfma32(kpA[1], aqB[1], Am);
            Bm = mfma32(kpA[0], kqB[0], Bm); Bm = mfma32(kpA[1], kqB[1], Bm);
            Fmm = mfma32(rpA[0], aqB[0], Fmm); Fmm = mfma32(rpA[1], aqB[1], Fmm);
#pragma unroll
            for (int q = 0; q < 4; ++q) { const int t = 4 * g + q; Am[q] = (row < t) ? Am[q] : 0.f; Bm[q] = (row < t) ? Bm[q] : 0.f; AL[t * 16 + row] = Am[q]; }
            SP_PUT16(gFm, ridx, (row <= 4 * g + q) ? Fmm[q] : 0.f);
            asm volatile("" ::: "memory");
            float Tc[16];
#pragma unroll
            for (int t = 0; t < 16; ++t) { float acc = (row == t) ? 1.0f : 0.f;
                f32x4 ar[4];
#pragma unroll
                for (int q = 0; q < 4; ++q) ar[q] = *(const LAS f32x4*)(AL + t * 16 + 4 * q);
#pragma unroll
                for (int i = 0; i < 16; ++i) if (i < t) acc -= ar[i >> 2][i & 3] * Tc[i];
                Tc[t] = acc; TI[t * 16 + row] = (bf16)f2bf(acc); }
            asm volatile("" ::: "memory");
            const v2u tB = *(const LAS v2u*)((const LAS unsigned char*)TI + row * 32 + g * 8);
#pragma unroll
            for (int pr = 0; pr < 2; ++pr) { const v2u ka = *(const LAS v2u*)(KpT + (32 * pr + row) * 40 + g * 8), kb2 = *(const LAS v2u*)(KpT + (32 * pr + 16 + row) * 40 + g * 8);
                const f32x4 d = mfma16(ka, tB, (f32x4){0.f, 0.f, 0.f, 0.f}), d2 = mfma16(kb2, tB, (f32x4){0.f, 0.f, 0.f, 0.f});
                *(v4u*)((char*)gK2 + (size_t)ridx * 2048 + pr * 1024 + lane * 16) = (v4u){pk2(d[0], d[1]), pk2(d[2], d[3]), pk2(d2[0], d2[1]), pk2(d2[2], d2[3])}; }
            { const v2u bB = (v2u){pk2(Bm[0], Bm[1]), pk2(Bm[2], Bm[3])};
              const f32x4 d = mfma16(tB, bB, (f32x4){0.f, 0.f, 0.f, 0.f});
              SP_PUT16(gTB, ridx, d[q]); }
#undef SP_PUT16
        }
        asm volatile("s_waitcnt lgkmcnt(0)" ::: "memory");
}
__device__ __forceinline__ void p_scanpre(Frame& F, int L) {
    LAS unsigned char* wl = F.lds + F.wave * SPL_WAVE;
    LAS bf16* RpI = (LAS bf16*)wl; LAS bf16* KqI = (LAS bf16*)(wl + SPL_IMG); LAS bf16* AqI = (LAS bf16*)(wl + 2 * SPL_IMG); LAS bf16* KpI = (LAS bf16*)(wl + 3 * SPL_IMG); LAS bf16* UaI = (LAS bf16*)(wl + 4 * SPL_IMG);
    LAS unsigned char* KpT = wl + SPL_KPT; LAS float* AL = (LAS float*)(wl + SPL_AL); LAS bf16* TI = (LAS bf16*)(wl + SPL_TI);
    const bf16* cr = (const bf16*)(F.ws + WS_CR);
    bf16* gRp = (bf16*)(F.ws + SP_RP); bf16* gKqT = (bf16*)(F.ws + SP_KQT); bf16* gE = (bf16*)(F.ws + SP_E); float* gPC = (float*)(F.ws + SP_PC); float* gBS = (float*)(F.ws + SP_BS);
    bf16* gVT = (bf16*)(F.ws + SP_VT); bf16* gK2 = (bf16*)(F.ws + SP_K2); bf16* gTB = (bf16*)(F.ws + SP_TB); bf16* gFm = (bf16*)(F.ws + SP_FM); bf16* gAqT = (bf16*)(F.ws + SP_AQT);
    const int lane = F.lane, row = lane & 15, g = lane >> 4;
    const int gw = F.vcu * NWAVES + F.wave, NGW = F.G * NWAVES;
#define SP_HT(x) ((((x) & 7) >> 1) + 4 * ((x) & 1))
    SpRaw raw; sp_fetch(raw, F, L, SP_HT(F.wave) * 2048 + gw, lane);
    for (int k = 0; k < 16384 / NGW; ++k) {
        const int it = SP_HT(k + F.wave) * 2048 + gw, itn = SP_HT(k + 1 + F.wave) * 2048 + gw;
        const int head8 = it >> 11, b = (it >> 7) & 15, chunk = it & 127;
        { const int so = (lane >> 3) * 144 + (lane & 7) * 16;
#pragma unroll
          for (int i = 0; i < 5; ++i)
#pragma unroll
              for (int j = 0; j < 2; ++j) *(LAS v4u*)(wl + i * SPL_IMG + j * 8 * 144 + so) = raw.a[i][j]; }
        float prm[6]; unsigned short prev[3];
#pragma unroll
        for (int i = 0; i < 6; ++i) prm[i] = raw.prm[i];
#pragma unroll
        for (int i = 0; i < 3; ++i) prev[i] = raw.prev[i];
        if (k + 1 < 16384 / NGW) sp_fetch(raw, F, L, itn, lane);
        if (head8 < 4) sp_item<true>(F, L, wl, it, b, head8, chunk, lane, prm, prev); else sp_item<false>(F, L, wl, it, b, head8 - 4, chunk, lane, prm, prev);
    }
}
constexpr int RC_RP = 0, RC_K2 = 2048, RC_KQT = 4096, RC_AQT = 6144, RC_VT = 8192, RC_E = 10240, RC_TB = 10752, RC_FM = 11264, RC_PC = 11776, RC_BS = 12032, RC_GT = 12288, RC_BYTES = 14336;
constexpr int SS_NSLOT = 8, SS_DEPTH = 6, SS_XCH = SS_NSLOT * RC_BYTES;
static_assert(SS_XCH + 8192 + 8192 <= RING_BYTES, "scan ring LDS");
#define SS_BARRIER() do { asm volatile("s_waitcnt lgkmcnt(0)" ::: "memory"); __builtin_amdgcn_s_barrier(); asm volatile("" ::: "memory"); } while (0)
template <bool RW>
__device__ __forceinline__ void ss_head(Frame& F, int L, int b, int hd) {
    const int lane = F.lane, row = lane & 15, g = lane >> 4, vs = F.wave & 3; const bool cons = F.wave < 4;
    const int vcol = vs * 16 + row, ch = hd * 64 + vcol;
    const int cbase = (b * 8 + (RW ? hd : 4 + hd)) * 128, rbase = (b * 4 + hd) * 128; const size_t mb = (size_t)b * T;
    LAS unsigned char* ring = F.lds; LAS float* xch = (LAS float*)(F.lds + SS_XCH);
    LAS unsigned char* ytile = F.lds + SS_XCH + 8192;
    if (!cons) {
        const int ll = (F.wave - 4) * 64 + lane;
        const char* src[4]; unsigned stride[4]; bool on[4];
        {
          if (ll < 128) { src[0] = (const char*)(F.ws + SP_RP) + (size_t)cbase * 2048 + ll * 16; stride[0] = 2048; on[0] = true; }
          else { src[0] = (const char*)(F.ws + SP_K2) + (size_t)rbase * 2048 + (ll - 128) * 16; stride[0] = 2048; on[0] = RW; }
          if (ll < 128) { src[1] = (const char*)(F.ws + SP_KQT) + (size_t)cbase * 2048 + ll * 16; stride[1] = 2048; on[1] = true; }
          else { src[1] = (const char*)(F.ws + SP_AQT) + (size_t)rbase * 2048 + (ll - 128) * 16; stride[1] = 2048; on[1] = RW; }
          if (ll < 128) { src[2] = (const char*)(F.ws + SP_VT) + (size_t)cbase * 2048 + ll * 16; stride[2] = 2048; on[2] = true; }
          else if (ll < 160) { src[2] = (const char*)(F.ws + SP_E) + (size_t)cbase * 512 + (ll - 128) * 16; stride[2] = 512; on[2] = true; }
          else if (ll < 192) { src[2] = (const char*)(F.ws + SP_TB) + (size_t)rbase * 512 + (ll - 160) * 16; stride[2] = 512; on[2] = RW; }
          else if (ll < 224) { src[2] = (const char*)(F.ws + SP_FM) + (size_t)rbase * 512 + (ll - 192) * 16; stride[2] = 512; on[2] = RW; }
          else if (ll < 240) { src[2] = (const char*)(F.ws + SP_PC) + (size_t)cbase * 256 + (ll - 224) * 16; stride[2] = 256; on[2] = true; }
          else if (ll < 244) { src[2] = (const char*)(F.ws + SP_BS) + (size_t)rbase * 64 + (ll - 240) * 16; stride[2] = 64; on[2] = RW; }
          else { src[2] = (const char*)(F.ws + SP_PC); stride[2] = 0; on[2] = false; }
          if (ll < 128) { const int r = ll >> 3, c16 = ll & 7;
              src[3] = RW ? (const char*)(F.ws + WS_LO) + (mb + r) * 1536 + 1024 + hd * 128 + c16 * 16 : (const char*)(F.ws + WS_CH) + (mb + r) * 2048 + 1536 + hd * 128 + c16 * 16;
              stride[3] = RW ? 16 * 1536 : 16 * 2048; on[3] = true; }
          else { src[3] = (const char*)(F.ws + SP_PC); stride[3] = 0; on[3] = false; } }
        (void)on;
        const int lw = F.wave - 4, nj = (lw < 2) ? 4 : 3;
        bf16* y = (bf16*)(F.ws + WS_H);
        LAS unsigned short* otile = (LAS unsigned short*)(F.lds + SS_XCH + 4096 + vs * 512);
        float p0 = 0.f, p1 = 0.f;
        if (RW) { p0 = AIN(I_LNW)[L * 256 + ch]; p1 = AIN(I_LNB)[L * 256 + ch]; } else p0 = AIN(I_GN)[L * 256 + ch];
        const unsigned l8o = (unsigned)lane * 8u;
        auto out_stage = [&](int c) {
            const LAS unsigned char* rec = ring + (c % SS_NSLOT) * RC_BYTES;
            const f32x4 Yp = *(const LAS f32x4*)(ytile + (((c & 1) * 4 + vs) * 64 + lane) * 16);
            const v2u vtp = *(const LAS v2u*)(rec + RC_VT + 512 * vs + l8o);
            f32x4 bsp = (f32x4){0.f, 0.f, 0.f, 0.f}; if (RW) bsp = *(const LAS f32x4*)(rec + RC_BS + 16 * g);
            float vv[4]; unpk4(vtp, vv);
#pragma unroll
            for (int q = 0; q < 4; ++q) { const int t = 4 * g + q;
                const unsigned short gtq = *(const LAS unsigned short*)(rec + RC_GT + t * 128 + vcol * 2);
                f32x2 ts = *(const LAS f32x2*)(xch + (((c & 1) * 4 + 0) * 16 + t) * 2);
#pragma unroll
                for (int w = 1; w < 4; ++w) ts += *(const LAS f32x2*)(xch + (((c & 1) * 4 + w) * 16 + t) * 2);
                const float t1 = ts.x, t2 = ts.y;
                const float gate = bf2f(gtq); float o;
                if (RW) { const float mean = t1 * (1.f / 64.f), var = t2 * (1.f / 64.f) - mean * mean;
                    o = ((Yp[q] - mean) * __builtin_amdgcn_rsqf(fmaxf(var, 0.f) + 64e-5f) * p0 + p1 + bsp[q] * vv[q]) * gate; }
                else o = Yp[q] * __builtin_amdgcn_rsqf(t2 * (1.f / 64.f) + 1e-6f) * p0 * siluf_(gate);
                otile[t * 16 + row] = (unsigned short)f2bf(o); }
            asm volatile("s_waitcnt lgkmcnt(0)" ::: "memory");
            const v2u ov = *(const LAS v2u*)((const LAS unsigned char*)otile + lane * 8);
            asm volatile("s_waitcnt lgkmcnt(0)" ::: "memory");
            *(v2u*)(y + (mb + (size_t)c * 16 + (lane >> 2)) * 1024 + (RW ? 0 : 768) + hd * 64 + vs * 16 + 4 * (lane & 3)) = ov;
        };
        const char* cur[4];
#pragma unroll
        for (int j = 0; j < 4; ++j) cur[j] = src[j];
        auto issue = [&](int k) { LAS unsigned char* slot = ring + (k % SS_NSLOT) * RC_BYTES + lw * 1024;
#pragma unroll
            for (int j = 0; j < 4; ++j) if (j < nj) __builtin_amdgcn_global_load_lds((const unsigned*)cur[j], (LAS unsigned*)(slot + j * 4096), 16, 0, 0);
            if (k < 127) {
#pragma unroll
                for (int j = 0; j < 4; ++j) cur[j] += stride[j]; } };
        for (int k = 0; k < SS_DEPTH; ++k) issue(k);
        if (nj == 4) asm volatile("s_waitcnt vmcnt(%0)" :: "n"((SS_DEPTH - 1) * 4) : "memory"); else asm volatile("s_waitcnt vmcnt(%0)" :: "n"((SS_DEPTH - 1) * 3) : "memory");
        SS_BARRIER();
#pragma unroll 1
        for (int c = 0; c < 128; ++c) {
            issue(c + SS_DEPTH);
            if (c > 0) out_stage(c - 1);
            if (nj == 4) asm volatile("s_waitcnt vmcnt(%0)" :: "n"((SS_DEPTH - 1) * 4) : "memory"); else asm volatile("s_waitcnt vmcnt(%0)" :: "n"((SS_DEPTH - 1) * 3) : "memory");
            SS_BARRIER(); }
        out_stage(127);
        asm volatile("s_waitcnt vmcnt(0)" ::: "memory");
        return;
    }
    f32x4 S[4];
#pragma unroll
    for (int i = 0; i < 4; ++i) S[i] = (f32x4){0.f, 0.f, 0.f, 0.f};
    const unsigned l8 = (unsigned)lane * 8u;
    SS_BARRIER();
#pragma unroll 1
    for (int c = 0; c < 128; ++c) {
        const LAS unsigned char* rec = ring + (c % SS_NSLOT) * RC_BYTES;
        v4u rpp[2], k2p[2]; v2u kqt[4], aqt[4]; f32x4 pc[4];
#pragma unroll
        for (int i = 0; i < 4; ++i) { kqt[i] = *(const LAS v2u*)(rec + RC_KQT + 512 * i + l8); pc[i] = *(const LAS f32x4*)(rec + RC_PC + 64 * i + 16 * g);
            if (RW) aqt[i] = *(const LAS v2u*)(rec + RC_AQT + 512 * i + l8); }
#pragma unroll
        for (int pr = 0; pr < 2; ++pr) { rpp[pr] = *(const LAS v4u*)(rec + RC_RP + 1024 * pr + 2 * l8); if (RW) k2p[pr] = *(const LAS v4u*)(rec + RC_K2 + 1024 * pr + 2 * l8); }
        const v2u e_ = *(const LAS v2u*)(rec + RC_E + l8), vt = *(const LAS v2u*)(rec + RC_VT + 512 * vs + l8);
        f32x4 Y = (f32x4){0.f, 0.f, 0.f, 0.f}, Z = Y;
        const v4u sb0 = (v4u){cvt_pk_bf16(S[0][0], S[0][1]), cvt_pk_bf16(S[0][2], S[0][3]), cvt_pk_bf16(S[1][0], S[1][1]), cvt_pk_bf16(S[1][2], S[1][3])};
        const v4u sb1 = (v4u){cvt_pk_bf16(S[2][0], S[2][1]), cvt_pk_bf16(S[2][2], S[2][3]), cvt_pk_bf16(S[3][0], S[3][1]), cvt_pk_bf16(S[3][2], S[3][3])};
        Y = mfma32(rpp[0], sb0, Y); Y = mfma32(rpp[1], sb1, Y);
        Y = mfma16(e_, vt, Y);
        v2u zn = (v2u){0u, 0u};
        if (RW) { const v2u tb = *(const LAS v2u*)(rec + RC_TB + l8), fm = *(const LAS v2u*)(rec + RC_FM + l8);
            Z = mfma32(k2p[0], sb0, Z); Z = mfma32(k2p[1], sb1, Z);
            Z = mfma16(tb, vt, Z);
            zn = (v2u){cvt_pk_bf16(-Z[0], -Z[1]), cvt_pk_bf16(-Z[2], -Z[3])};
            Y = mfma16(fm, zn, Y); }
        *(LAS f32x4*)(ytile + (((c & 1) * 4 + vs) * 64 + lane) * 16) = Y;
#pragma unroll
        for (int q = 0; q < 4; ++q) { const float s1 = row16_sum(Y[q]), s2 = row16_sum(Y[q] * Y[q]);
            if (row == 0) *(LAS f32x2*)(xch + (((c & 1) * 4 + vs) * 16 + 4 * g + q) * 2) = (f32x2){s1, s2}; }
#pragma unroll
        for (int tile = 0; tile < 4; ++tile) { f32x4 d = mfma16(kqt[tile], vt, S[tile]); if (RW) d = mfma16(aqt[tile], zn, d); S[tile] = d * pc[tile]; }
        SS_BARRIER();
    }
}
__device__ __forceinline__ void p_scanseq(Frame& F, int L, int mode) {
    const int pair = F.vcu; if (pair < 128 && (mode & 1)) return; if (pair >= 128 && (mode & 2)) return; if (pair >= 128) { if (L == 0) p_moe_weights2(F); else { Frame G2 = F; G2.vcu = F.vcu - 128; G2.G = 128; p_moe_weights(F, G2, 2, NEXP); } return; }
    const int b = pair >> 3, head8 = pair & 7;
    if (head8 < 4) ss_head<true>(F, L, b, head8); else ss_head<false>(F, L, b, head8 - 4);
}

constexpr int AT_KSTRB = 208, AT_VSTRB = 192;
constexpr int AT_KB = 64 * AT_KSTRB, AT_VB = 64 * AT_VSTRB, AT_BUF = AT_KB + AT_VB;
static_assert(2 * AT_BUF <= RING_BYTES, "attention LDS");
typedef short v4i16_t __attribute__((ext_vector_type(4)));
__device__ __forceinline__ int crow(int r) { return (r & 3) + 8 * (r >> 2); }
__device__ __forceinline__ bf16x8 scale_frag(bf16x8 q, float c) { v4u w = __builtin_bit_cast(v4u, q); v4u o;
    o.x = cvt_pk_bf16(bflo(w.x) * c, bfhi(w.x) * c); o.y = cvt_pk_bf16(bflo(w.y) * c, bfhi(w.y) * c); o.z = cvt_pk_bf16(bflo(w.z) * c, bfhi(w.z) * c); o.w = cvt_pk_bf16(bflo(w.w) * c, bfhi(w.w) * c);
    return __builtin_bit_cast(bf16x8, o); }
template <int DQ, bool DIL>
__device__ __forceinline__ void attn_unit(Frame& F, const bf16* Qp, int ldq, const bf16* K1, int ldk1, const bf16* K2, int ldk2, const bf16* Vp, int ldv, bf16* Op, int ldo, int q0, float c1) {
    constexpr int NS = DQ / 16;
    int tid_ = F.tid; asm volatile("" : "+v"(tid_));
    const int tid = tid_, lane = tid & 63, r = lane & 31, h = lane >> 5, wid = F.wave;
    const int qi = q0 + wid * 32 + r;
    bf16x8 qr[NS];
#pragma unroll
    for (int s = 0; s < NS; ++s) qr[s] = scale_frag(*(const bf16x8*)(Qp + (size_t)qi * ldq + 16 * s + 8 * h), c1);
    f32x16 o0, o1;
#pragma unroll
    for (int i = 0; i < 16; ++i) { o0[i] = 0.f; o1[i] = 0.f; }
    float mrun = -1.0e30f, lrun = 0.f;
    const int ntile = (q0 + 256) / 64; const int qlo = q0 + wid * 32, qhi = qlo + 31;
    const int skey = tid >> 3, sc = tid & 7, skey2 = tid >> 2, sc2 = tid & 3;
    const int li = lane & 15, tq = li >> 2, tp = li & 3, tg = (lane >> 4) & 1;
    const int vtoff = (4 * h + tq) * AT_VSTRB + (16 * tg + 4 * tp) * 2;
    v4u gk, gk2 = (v4u){0, 0, 0, 0}, gv;
    gk = *(const v4u*)(K1 + (size_t)skey * ldk1 + sc * 8); gv = *(const v4u*)(Vp + (size_t)skey * ldv + sc * 8);
    if (DQ == 96 && tid < 256) gk2 = *(const v4u*)(K2 + (size_t)skey2 * ldk2 + sc2 * 8);
    const int dres = qi - 4 * h, j0_ = dres & 3, q4_ = (dres - j0_) & 15;
    bool dB[4], dC[4][2];
#pragma unroll
    for (int j = 0; j < 4; ++j) { dB[j] = DIL && (j0_ == j); dC[j][0] = dB[j] && (q4_ == 0); dC[j][1] = dB[j] && (q4_ == 8); }
    __syncthreads();
    for (int t = 0; t < ntile; ++t) {
        const int k0 = t * 64;
        LAS unsigned char* kb_ = F.lds + (t & 1) * AT_BUF; LAS unsigned char* vb_ = kb_ + AT_KB;
        *(LAS v4u*)(kb_ + skey * AT_KSTRB + sc * 16) = gk;
        if (DQ == 96 && tid < 256) *(LAS v4u*)(kb_ + skey2 * AT_KSTRB + 128 + sc2 * 16) = gk2;
        *(LAS v4u*)(vb_ + skey * AT_VSTRB + sc * 16) = gv;
        __syncthreads();
        if (t + 1 < ntile) { const size_t kn = (size_t)(k0 + 64);
            gk = *(const v4u*)(K1 + (kn + skey) * ldk1 + sc * 8); gv = *(const v4u*)(Vp + (kn + skey) * ldv + sc * 8);
            if (DQ == 96 && tid < 256) gk2 = *(const v4u*)(K2 + (kn + skey2) * ldk2 + sc2 * 8); }
        if (k0 > qhi) continue;
        f32x16 p[2];
#pragma unroll
        for (int kb = 0; kb < 2; ++kb) {
            bf16x8 kf[NS];
#pragma unroll
            for (int s = 0; s < NS; ++s) kf[s] = *(const LAS bf16x8*)(kb_ + (kb * 32 + r) * AT_KSTRB + (16 * s + 8 * h) * 2);
            asm volatile("s_waitcnt lgkmcnt(0)" ::: "memory");
#pragma unroll
            for (int i = 0; i < 16; ++i) p[kb][i] = 0.f;
#pragma unroll
            for (int s = 0; s < NS; ++s) p[kb] = __builtin_amdgcn_mfma_f32_32x32x16_bf16(kf[s], qr[s], p[kb], 0, 0, 0);
        }
        v4i16_t vf[2][2][4];
#pragma unroll
        for (int kb = 0; kb < 2; ++kb)
#pragma unroll
            for (int s2 = 0; s2 < 2; ++s2) { const LAS unsigned char* vp = vb_ + (kb * 32 + 16 * s2) * AT_VSTRB + vtoff;
                vf[kb][s2][0] = __builtin_amdgcn_ds_read_tr16_b64_v4i16((LAS v4i16_t*)(vp)); vf[kb][s2][1] = __builtin_amdgcn_ds_read_tr16_b64_v4i16((LAS v4i16_t*)(vp + 8 * AT_VSTRB));
                vf[kb][s2][2] = __builtin_amdgcn_ds_read_tr16_b64_v4i16((LAS v4i16_t*)(vp + 64)); vf[kb][s2][3] = __builtin_amdgcn_ds_read_tr16_b64_v4i16((LAS v4i16_t*)(vp + 64 + 8 * AT_VSTRB)); }
        const int dbase = qi - k0 - 4 * h;
        const int dmin = qlo - (k0 + 63);
        const int dmax = qhi - k0;
        if (DIL) {
            if (dmin > 512) {
#pragma unroll
                for (int kb = 0; kb < 2; ++kb)
#pragma unroll
                    for (int i = 0; i < 16; ++i) p[kb][i] = dC[i & 3][(i >> 2) & 1] ? p[kb][i] : -INFINITY;
            } else if (dmin > 128 && dmax <= 512) {
#pragma unroll
                for (int kb = 0; kb < 2; ++kb)
#pragma unroll
                    for (int i = 0; i < 16; ++i) { const float x = p[kb][i]; p[kb][i] = dC[i & 3][(i >> 2) & 1] ? x + 1.0f : (dB[i & 3] ? x : -INFINITY); }
            } else if (dmin >= 0 && dmax <= 128) {
#pragma unroll
                for (int kb = 0; kb < 2; ++kb)
#pragma unroll
                    for (int i = 0; i < 16; ++i) { const float x = p[kb][i]; p[kb][i] = dC[i & 3][(i >> 2) & 1] ? x + 1.5849625007211562f : (dB[i & 3] ? x + 1.0f : x); }
            } else if (dmin > 128) {
#pragma unroll
                for (int kb = 0; kb < 2; ++kb)
#pragma unroll
                    for (int i = 0; i < 16; ++i) { const int dl = dbase - 32 * kb - crow(i); const bool le = dl <= 512;
                        const float tC = le ? 1.0f : 0.0f, tB = le ? 0.0f : -INFINITY;
                        p[kb][i] += dC[i & 3][(i >> 2) & 1] ? tC : (dB[i & 3] ? tB : -INFINITY); }
            } else {
#pragma unroll
                for (int kb = 0; kb < 2; ++kb)
#pragma unroll
                    for (int i = 0; i < 16; ++i) { const int dl = dbase - 32 * kb - crow(i); const bool a = (unsigned)dl <= 128u;
                        const float t0 = a ? 0.0f : -INFINITY, tB = a ? 1.0f : 0.0f, tC = a ? 1.5849625007211562f : 1.0f;
                        float bias = dC[i & 3][(i >> 2) & 1] ? tC : (dB[i & 3] ? tB : t0);
                        if (dmin < 0) bias = (dl < 0) ? -INFINITY : bias;
                        p[kb][i] += bias; }
            }
        } else if (dmin < 0) {
#pragma unroll
            for (int kb = 0; kb < 2; ++kb)
#pragma unroll
                for (int i = 0; i < 16; ++i) { const int dl = dbase - 32 * kb - crow(i); p[kb][i] = (dl < 0) ? -INFINITY : p[kb][i]; }
        }
        float mx = fmaxf(p[0][0], p[1][0]);
#pragma unroll
        for (int i = 1; i < 16; ++i) mx = fmaxf(mx, fmaxf(p[0][i], p[1][i]));
        mx = fmaxf(mx, __shfl_xor(mx, 32));
        const float mnew = fmaxf(mrun, mx);
        if (!__all(mnew == mrun)) { const float alpha = __builtin_amdgcn_exp2f(mrun - mnew); lrun *= alpha;
#pragma unroll
            for (int i = 0; i < 16; ++i) { o0[i] *= alpha; o1[i] *= alpha; } }
        mrun = mnew;
        float rsum = 0.f;
#pragma unroll
        for (int kb = 0; kb < 2; ++kb)
#pragma unroll
            for (int i = 0; i < 16; ++i) { const float e = __builtin_amdgcn_exp2f(p[kb][i] - mnew); p[kb][i] = e; rsum += e; }
        lrun += rsum;
        asm volatile("s_waitcnt lgkmcnt(0)" ::: "memory");
#pragma unroll
        for (int kb = 0; kb < 2; ++kb)
#pragma unroll
            for (int s2 = 0; s2 < 2; ++s2) {
                v4u pw; pw.x = cvt_pk_bf16(p[kb][8 * s2 + 0], p[kb][8 * s2 + 1]); pw.y = cvt_pk_bf16(p[kb][8 * s2 + 2], p[kb][8 * s2 + 3]);
                pw.z = cvt_pk_bf16(p[kb][8 * s2 + 4], p[kb][8 * s2 + 5]); pw.w = cvt_pk_bf16(p[kb][8 * s2 + 6], p[kb][8 * s2 + 7]);
                const bf16x8 pb = __builtin_bit_cast(bf16x8, pw);
                const v4i16_t a00 = vf[kb][s2][0], a01 = vf[kb][s2][1], a10 = vf[kb][s2][2], a11 = vf[kb][s2][3];
                const bf16x8 av0 = (bf16x8){a00[0], a00[1], a00[2], a00[3], a01[0], a01[1], a01[2], a01[3]};
                const bf16x8 av1 = (bf16x8){a10[0], a10[1], a10[2], a10[3], a11[0], a11[1], a11[2], a11[3]};
                o0 = __builtin_amdgcn_mfma_f32_32x32x16_bf16(av0, pb, o0, 0, 0, 0);
                o1 = __builtin_amdgcn_mfma_f32_32x32x16_bf16(av1, pb, o1, 0, 0, 0);
            }
    }
    lrun += __shfl_xor(lrun, 32);
    const float inv = frcp(lrun);
    bf16* orow = Op + (size_t)qi * ldo;
#pragma unroll
    for (int g = 0; g < 4; ++g) {
        v2u w0, w1; w0.x = pk2(o0[4 * g] * inv, o0[4 * g + 1] * inv); w0.y = pk2(o0[4 * g + 2] * inv, o0[4 * g + 3] * inv);
        w1.x = pk2(o1[4 * g] * inv, o1[4 * g + 1] * inv); w1.y = pk2(o1[4 * g + 2] * inv, o1[4 * g + 3] * inv);
        *(v2u*)(orow + 8 * g + 4 * h) = w0; *(v2u*)(orow + 32 + 8 * g + 4 * h) = w1;
    }
}
__device__ __forceinline__ void p_attn(Frame& F) {
    const int v = F.vcu, bh = v >> 2, s = v & 3, b = bh >> 2, hd = bh & 3; const size_t row0 = (size_t)b * T;
    const bf16* cd = (const bf16*)(F.ws + WS_CD) + row0 * 768 + hd * 64; const bf16* cm = (const bf16*)(F.ws + WS_CM) + row0 * 512 + 384;
    const bf16* qm = (const bf16*)(F.ws + WS_QM) + row0 * 384 + hd * 96; const bf16* kvm = (const bf16*)(F.ws + WS_KVM) + row0 * 512 + hd * 128;
    bf16* y = (bf16*)(F.ws + WS_H) + row0 * 1024;
    for (int i = 0; i < 2; ++i) { const int qb = i == 0 ? s : 7 - s;
        attn_unit<64, true>(F, cd, 768, cd + 256, 768, nullptr, 0, cd + 512, 768, y + 256 + hd * 64, 1024, qb * 256, 0.125f * 1.4426950408889634f);
        attn_unit<96, false>(F, qm, 384, kvm, 512, cm, 512, kvm + 64, 512, y + 512 + hd * 64, 1024, qb * 256, 0.10206207261596577f * 1.4426950408889634f); }
}

constexpr int PH_PRO = 0, PH_L = 12;
constexpr int PH_SCAT = 23, PH_UP0 = 24, PH_DN0 = 25, PH_UP1 = 26, PH_DN1 = 27, PH_FIN = 28, N_PHASES = 29;

#define PHASE_FN __device__ __forceinline__ void
#define ROPE_PTRS const float* cosd = (const float*)(F.ws + WS_ROPE); const float* sind = cosd + (size_t)M * 32; const float* cosm = sind + (size_t)M * 32; const float* sinm = cosm + (size_t)M * 16
PHASE_FN ph_prologue() { Frame F; frame_init(F); p_prologue(F); }
#define XB ((bf16*)(F.out + (size_t)M * D / 2))
PHASE_FN ph_norm1(int L) { Frame F; frame_init(F); L = __builtin_amdgcn_readfirstlane(L);
    if (L == 0) norm_rows(F, AIN(I_X), AIN(I_MIXN), (bf16*)(F.ws + WS_H)); else norm_rows_b(F, XB, AIN(I_MIXN) + L * D, (bf16*)(F.ws + WS_H)); }
PHASE_FN ph_gemm1(int L) { Frame F; frame_init(F); L = __builtin_amdgcn_readfirstlane(L); unsigned char* ws = F.ws; ROPE_PTRS;
    pg8::Gemm g{(const bf16*)(ws + WS_H), (const bf16*)(ws + WS_WIN) + (size_t)L * NINP * D, D, D, D}; pg8::StaticOrder S; S.init(M / 256, NINP / 256, F.G, (int)blockIdx.x);
    pg8::EpiCols E{(bf16*)(ws + WS_CR), (bf16*)(ws + WS_CD), (bf16*)(ws + WS_CM), (bf16*)(ws + WS_CH), cosd, sind, cosm, sinm};
    pg8::gemm_phase<pg8::EpiCols, pg8::StaticOrder>(F.lds, g, S, E);
    if ((int)blockIdx.x >= 128) { __syncthreads(); Frame G2 = F; G2.vcu = (int)blockIdx.x - 128; G2.G = 128;
        if (L == 0) p_blockmats(G2); else p_moe_weights(F, G2, 0, 2); } }
PHASE_FN ph_prepA(int L) { Frame F; frame_init(F); L = __builtin_amdgcn_readfirstlane(L); p_prepA(F, L); }
PHASE_FN ph_lora(int L) { Frame F; frame_init(F); L = __builtin_amdgcn_readfirstlane(L); unsigned char* ws = F.ws;
    pg8::Gemm g{(const bf16*)(ws + WS_AL), (const bf16*)(ws + WS_WLORA) + (size_t)L * 768 * 256, 256, 256, 256}; pg8::StaticOrder S; S.init(M / 256, 3, F.G, (int)blockIdx.x);
    pg8::EpiLora E{(bf16*)(ws + WS_LO), AIN(I_W0) + L * 256, AIN(I_A0) + L * 256};
    pg8::gemm_phase<pg8::EpiLora, pg8::StaticOrder>(F.lds, g, S, E); }
PHASE_FN ph_mla(int L) { Frame F; frame_init(F); L = __builtin_amdgcn_readfirstlane(L); unsigned char* ws = F.ws; ROPE_PTRS; (void)cosd; (void)sind;
    pg8::Gemm g{(const bf16*)(ws + WS_CM), (const bf16*)(ws + WS_WMLA) + (size_t)L * 1024 * 384, 384, 512, 384}; pg8::StaticOrder S; S.init(M / 256, 4, F.G, (int)blockIdx.x);
    pg8::EpiMla E{(bf16*)(ws + WS_QM), (bf16*)(ws + WS_KVM), (const float*)(ws + MS_RS), cosm, sinm};
    pg8::gemm_phase<pg8::EpiMla, pg8::StaticOrder>(F.lds, g, S, E); }
PHASE_FN ph_attn() { Frame F; frame_init(F); p_attn(F); }
PHASE_FN ph_scanpre(int L) { Frame F; frame_init(F); L = __builtin_amdgcn_readfirstlane(L); p_scanpre(F, L); }
PHASE_FN ph_scanseq(int L, int mode) { Frame F; frame_init(F); L = __builtin_amdgcn_readfirstlane(L); mode = __builtin_amdgcn_readfirstlane(mode); p_scanseq(F, L, mode); }
PHASE_FN ph_gemm2(int L) { Frame F; frame_init(F); L = __builtin_amdgcn_readfirstlane(L); unsigned char* ws = F.ws;
    pg8::Gemm g{(const bf16*)(ws + WS_H), (const bf16*)(ws + WS_WOUT) + (size_t)L * D * D, D, D, D}; pg8::StaticOrder S; S.init(M / 256, 4, F.G, (int)blockIdx.x);
    pg8::EpiResid E{L == 0 ? AIN(I_X) : (const float*)nullptr, XB, XB};
    pg8::gemm_phase<pg8::EpiResid, pg8::StaticOrder>(F.lds, g, S, E); }
PHASE_FN ph_norm2d() { Frame F; frame_init(F); norm_rows_b(F, XB, AIN(I_FFNN), (bf16*)(F.ws + WS_H)); }
PHASE_FN ph_up_dense() { Frame F; frame_init(F); unsigned char* ws = F.ws;
    pg8::Gemm g{(const bf16*)(ws + WS_H), (const bf16*)(ws + WS_W13D), D, D, D}; pg8::StaticOrder S; S.init(M / 256, 2 * FF / 256, F.G, (int)blockIdx.x);
    pg8::EpiSwiglu E{(bf16*)(ws + WS_ACT), FF};
    pg8::gemm_phase<pg8::EpiSwiglu, pg8::StaticOrder>(F.lds, g, S, E); }
PHASE_FN ph_down_dense() { Frame F; frame_init(F); unsigned char* ws = F.ws;
    pg8::Gemm g{(const bf16*)(ws + WS_ACT), (const bf16*)(ws + WS_W2D), FF, FF, FF}; pg8::StaticOrder S; S.init(M / 256, 4, F.G, (int)blockIdx.x);
    pg8::EpiResid E{(const float*)nullptr, XB, XB};
    pg8::gemm_phase<pg8::EpiResid, pg8::StaticOrder>(F.lds, g, S, E); }
PHASE_FN ph_norm_router() { Frame F; frame_init(F); norm_router(F, XB, AIN(I_FFNN) + D, AIN(I_RT), (bf16*)(F.ws + WS_H)); }
PHASE_FN ph_scatter() { Frame F; frame_init(F); moe_scatter(F); }
PHASE_FN ph_moe_up(int s) { Frame F; frame_init(F); s = __builtin_amdgcn_readfirstlane(s); unsigned char* ws = F.ws;
    LAS int* tst = (LAS int*)(F.lds + MISC_OFF + 64); LAS int* texp = (LAS int*)(F.lds + MISC_OFF + 128);
    const int* rtok = (const int*)(ws + MS_RTOK) + s * MAXROWS;
    const int ntl = moe_tables(F, s, tst, texp);
    pg8::MoeUpOrder S; S.init(ntl, 2 * FFE / 256, F.G, (int)blockIdx.x); S.texp = texp;
    S.ebase = F.lds + ARGS_OFF + 8 * 40;
    if (F.tid < 8) { const int e = F.tid; *(LAS unsigned long long*)(F.lds + ARGS_OFF + 8 * 40 + 8 * e) = (unsigned long long)wm13_base(e, ws, F.out); }
    LAS int* gtab = (LAS int*)(F.lds + TAB_OFF);
    { int tk[16];
#pragma unroll
      for (int i = 0; i < 16; ++i) { pg8::Unit u; const bool ok = S.next(i, u); tk[i] = rtok[(ok ? u.pm : 0) * 256 + (F.tid & 255)]; }
#pragma unroll
      for (int i = 0; i < 16; ++i) if (F.tid < 256) gtab[i * 256 + F.tid] = tk[i]; }
    __syncthreads();
    pg8::Gemm g{(const bf16*)(ws + WS_H), (const bf16*)(ws + WS_WM13), D, D, D};
    pg8::EpiSwiglu E{(bf16*)(ws + WS_ACT), FFE};
    pg8::gemm_phase<pg8::EpiSwiglu, pg8::MoeUpOrder, true>(F.lds, g, S, E, gtab); }
__device__ __forceinline__ int moe_tail_ks(int ntail) { return ntail == 0 ? 1 : (ntail <= 17 ? 14 : (ntail <= 28 ? 7 : (ntail <= 98 ? 2 : 1))); }
constexpr size_t WS_PART = 384 * MiB;
PHASE_FN ph_moe_down(int s) { Frame F; frame_init(F); s = __builtin_amdgcn_readfirstlane(s); unsigned char* ws = F.ws;
    LAS int* tst = (LAS int*)(F.lds + MISC_OFF + 64); LAS int* texp = (LAS int*)(F.lds + MISC_OFF + 128);
    const int* rtok = (const int*)(ws + MS_RTOK) + s * MAXROWS; const float* rgate = (const float*)(ws + MS_RGATE) + s * MAXROWS;
    const int ntl = moe_tables(F, s, tst, texp);
    pg8::MoeOrder S; S.init(ntl, 4, F.G, (int)blockIdx.x); S.texp = texp;
    const int nfull = (S.nwg / F.G) * F.G, ntail = S.nwg - nfull, KS = moe_tail_ks(ntail);
    if (KS > 1) S.lim = nfull;
    { pg8::Gemm g{(const bf16*)(ws + WS_ACT), (const bf16*)(ws + WS_WM2), FFE, FFE, FFE};
      pg8::EpiMoeDown E{XB, s == 0 ? XB : (bf16*)(ws + WS_H), rtok, rgate};
      pg8::gemm_phase<pg8::EpiMoeDown, pg8::MoeOrder>(F.lds, g, S, E); }
    if (KS > 1) { pg8::MoeTailOrder St; St.init(ntl, 4, F.G, (int)blockIdx.x); St.texp = texp; St.first = nfull; St.KS = KS; St.Ksub = FFE / KS; St.nsub = ntail * KS;
      pg8::Gemm g{(const bf16*)(ws + WS_ACT), (const bf16*)(ws + WS_WM2), FFE / KS, FFE, FFE};
      pg8::EpiPartial E{(bf16*)(ws + WS_PART), nfull, KS};
      pg8::gemm_phase<pg8::EpiPartial, pg8::MoeTailOrder>(F.lds, g, St, E); } }
PHASE_FN ph_moe_tail_reduce(int s) { Frame F; frame_init(F); s = __builtin_amdgcn_readfirstlane(s); unsigned char* ws = F.ws;
    LAS int* tst = (LAS int*)(F.lds + MISC_OFF + 64); LAS int* texp = (LAS int*)(F.lds + MISC_OFF + 128);
    const int* rtok = (const int*)(ws + MS_RTOK) + s * MAXROWS; const float* rgate = (const float*)(ws + MS_RGATE) + s * MAXROWS;
    const int ntl = moe_tables(F, s, tst, texp);
    pg8::MoeOrder S; S.init(ntl, 4, F.G, (int)blockIdx.x); S.texp = texp;
    const int nfull = (S.nwg / F.G) * F.G, ntail = S.nwg - nfull, KS = moe_tail_ks(ntail);
    if (KS <= 1) return;
    const bf16* part = (const bf16*)(ws + WS_PART);
    const int gw = F.vcu * NWAVES + F.wave, NGW = F.G * NWAVES;
    for (int it = gw; it < ntail * 256; it += NGW) { const int tu = it >> 8, r = it & 255; pg8::Unit u; S.decode(nfull + tu, u);
        const int row = u.pm * 256 + r; const int tok = rtok[row]; const float gt = rgate[row];
        v2u pv[14];
#pragma unroll
        for (int k = 0; k < 14; ++k) if (k < KS) pv[k] = *(const v2u*)(part + ((size_t)(tu * KS + k) * 256 + r) * 256 + 4 * F.lane);
        f32x4 a = (f32x4){bflo(pv[0].x), bfhi(pv[0].x), bflo(pv[0].y), bfhi(pv[0].y)};
#pragma unroll
        for (int k = 1; k < 14; ++k) if (k < KS) a += (f32x4){bflo(pv[k].x), bfhi(pv[k].x), bflo(pv[k].y), bfhi(pv[k].y)};
        if (tok < 0) continue;
        const size_t xo = (size_t)tok * 1024 + u.pn * 256 + 4 * F.lane; const v2u w = *(const v2u*)(XB + xo);
        f32x4 xv; xv.x = __builtin_bit_cast(float, w.x << 16); xv.y = __builtin_bit_cast(float, w.x & 0xffff0000u); xv.z = __builtin_bit_cast(float, w.y << 16); xv.w = __builtin_bit_cast(float, w.y & 0xffff0000u);
        xv += a * gt; v2u ow; ow.x = pk2(xv.x, xv.y); ow.y = pk2(xv.z, xv.w);
        *(v2u*)((s == 0 ? XB : (bf16*)(ws + WS_H)) + xo) = ow; } }
PHASE_FN ph_final() { Frame F; frame_init(F); final_norm_rows(F, (const bf16*)(F.ws + WS_H), F.out, AIN(I_FN)); }

__global__ void __launch_bounds__(NWAVES * 64, 2) mega_fwd(Args args) {
    extern __shared__ __attribute__((aligned(16))) unsigned char lds[];
    LAS unsigned char* L = (LAS unsigned char*)lds;
    for (int u = threadIdx.x; u < 256; u += NWAVES * 64) ((LAS unsigned*)(L + MISC_OFF))[u] = 0u;
    if (threadIdx.x == 0) { LAS unsigned long long* ap = (LAS unsigned long long*)(L + ARGS_OFF);
#pragma unroll
        for (int i = 0; i < 31; ++i) ap[i] = (unsigned long long)args.in[i];
        ap[31] = (unsigned long long)args.out; ap[32] = (unsigned long long)args.ws; }
    __syncthreads();
#if MK_ONE_LAUNCH
    (void)xcd_barrier_post((unsigned*)(args.ws + WS_CTL) + CW_BAR, (volatile LAS unsigned*)(L + MISC_OFF) + 8);
#define GRID_BAR() xcd_barrier()
#else
#define GRID_BAR() do { } while (0)
#endif
    const int lo = args.ph_lo, hi = args.ph_hi;
#define IN(k) (lo <= (k) && (k) < hi)
#define SEAM(k) do { if (IN(k) && IN((k) + 1)) GRID_BAR(); } while (0)
    if (SITE(0) && IN(PH_PRO)) RUN(0, ph_prologue());
    for (int Ly = 0; Ly < DEPTH; ++Ly) {
        const int pb = 1 + PH_L * Ly;
        if (SITE(1) && IN(pb + 0)) RUN(1, ph_norm1(Ly)); SEAM(pb + 0);
        if (SITE(2) && IN(pb + 1)) RUN(2, ph_gemm1(Ly)); SEAM(pb + 1);
        if (SITE(3) && IN(pb + 2)) RUN(3, ph_prepA(Ly)); SEAM(pb + 2);
        if (IN(pb + 3)) RUN(4, { if (SITE(4)) ph_lora(Ly); if (SITE(18)) ph_mla(Ly); }); SEAM(pb + 3);
        if (SITE(5) && IN(pb + 4)) RUN(5, ph_attn()); SEAM(pb + 4);
        if (SITE(6) && IN(pb + 5)) RUN(6, ph_scanpre(Ly)); SEAM(pb + 5);
        if (SITE(7) && IN(pb + 6)) RUN(7, ph_scanseq(Ly, r_ > 0 ? SS_MODE : 0)); if (IN(pb + 6) && IN(pb + 8)) GRID_BAR();
        if (SITE(9) && IN(pb + 8)) ph_gemm2(Ly); SEAM(pb + 8);
        if (Ly == 0) {
            if (SITE(10) && IN(pb + 9)) ph_norm2d(); SEAM(pb + 9);
            if (SITE(11) && IN(pb + 10)) RUN(11, ph_up_dense()); SEAM(pb + 10);
            if (SITE(12) && IN(pb + 11)) ph_down_dense(); SEAM(pb + 11);
        } else {
            if (IN(pb + 9)) { if (SITE(13)) ph_norm_router(); } SEAM(pb + 9);
        }
    }
    if (SITE(14) && IN(PH_SCAT)) ph_scatter(); SEAM(PH_SCAT);
    for (int s = 0; s < 2; ++s) {
        if (SITE(15) && IN(PH_UP0 + 2 * s)) { if (s == 1) ph_moe_tail_reduce(0);
            RUN(15, ph_moe_up(s)); } SEAM(PH_UP0 + 2 * s);
        if (SITE(16) && IN(PH_DN0 + 2 * s)) { ph_moe_down(s); if (s == 1) { GRID_BAR(); ph_moe_tail_reduce(1); } } SEAM(PH_DN0 + 2 * s);
    }
    if (SITE(17) && IN(PH_FIN)) ph_final();
#undef IN
#undef SEAM
}

extern "C" void kernel_launch(void* const* d_in, const int* in_sizes, int n_in, void* d_out, int out_size, void* d_ws, size_t ws_size, hipStream_t stream) {
    static int grid = 0;
    if (grid == 0) {
        if (n_in != 31 || in_sizes[0] != M * D || out_size != M * D || ws_size < WS_END) { fprintf(stderr, "kernel_launch: unexpected shapes / workspace (%d inputs, ws %zu, need %zu)\n", n_in, ws_size, (size_t)WS_END); grid = -1; return; }
        int dev = 0, cus = 0, per_cu = 0;
        if (hipGetDevice(&dev) != hipSuccess || hipDeviceGetAttribute(&cus, hipDeviceAttributeMultiprocessorCount, dev) != hipSuccess) { grid = -1; return; }
        if (hipFuncSetAttribute((const void*)mega_fwd, hipFuncAttributeMaxDynamicSharedMemorySize, LDS_BYTES) != hipSuccess) { fprintf(stderr, "kernel_launch: hipFuncSetAttribute failed\n"); grid = -1; return; }
        if (hipOccupancyMaxActiveBlocksPerMultiprocessor(&per_cu, (const void*)mega_fwd, NWAVES * 64, LDS_BYTES) != hipSuccess || per_cu < 1) fprintf(stderr, "kernel_launch: occupancy query reports %d\n", per_cu);
        (void)hipGetLastError();
        grid = cus;
        if (grid != 256) { fprintf(stderr, "kernel_launch: built for 256 CUs, found %d\n", cus); grid = -1; return; }
    }
    if (grid < 0) return;
    (void)hipMemsetAsync((char*)d_ws + WS_CTL, 0, CTL_ZERO_BYTES, stream);
    Args a{};
    for (int i = 0; i < 31; ++i) a.in[i] = (const float*)d_in[i];
    a.out = (float*)d_out; a.ws = (unsigned char*)d_ws;
#if MK_ONE_LAUNCH
    a.ph_lo = 0; a.ph_hi = N_PHASES;
    hipLaunchKernelGGL(mega_fwd, dim3(grid), dim3(NWAVES * 64), LDS_BYTES, stream, a);
#else
    for (int p = 0; p < N_PHASES; ++p) { a.ph_lo = p; a.ph_hi = p + 1; hipLaunchKernelGGL(mega_fwd, dim3(grid), dim3(NWAVES * 64), LDS_BYTES, stream, a); }
#endif
}
```
